# Optimizing an MI355X kernel written in HIP

```python
import math
import jax, jax.numpy as jnp
from jax import lax
import numpy as np

D_MODEL = 1024
BATCH = 2
SEQ = 8192
DEPTH = 2

N_MEM = 256
N_MIXERS = 2
N_CONV_LAYERS = (DEPTH + 1) // 2
N_NSA_LAYERS = DEPTH // 2

CONV_WIDTH = 3

NSA_HEADS = 16
NSA_HEAD_DIM = D_MODEL // NSA_HEADS
NSA_KV_GROUPS = 4
NSA_HPG = NSA_HEADS // NSA_KV_GROUPS
CMP_BLOCK = 32
CMP_STRIDE = 16
CMP_HIDDEN = 2 * NSA_HEAD_DIM
SEL_BLOCK = 64
SEL_TOPK = 16
SEL_FORCE = 1.0e4
WINDOW = 512
Q_BLOCK = 128

XATTN_HEADS = 4
XATTN_HEAD_DIM = 128
XATTN_WIDTH = XATTN_HEADS * XATTN_HEAD_DIM
MIX_WIDTH = D_MODEL + XATTN_WIDTH

CONV_IN_WIDTH = 3 * D_MODEL + XATTN_WIDTH
NSA_IN_WIDTH = (NSA_HEADS * NSA_HEAD_DIM + 6 * NSA_KV_GROUPS * NSA_HEAD_DIM
                + 3 * NSA_HEADS + XATTN_WIDTH)

FFN_HIDDEN = ((8 * D_MODEL + 3 * 256 - 1) // (3 * 256)) * 256

REL_BUCKETS = 32
REL_MAX_DIST = 128
RMS_EPS = 1e-6
NEG = -1e30

kernel_name = "hybrid_shortconv_nsa_interleaved"


def rmsnorm(x, g):
    xf = x.astype(jnp.float32)
    y = xf * lax.rsqrt(jnp.mean(xf * xf, axis=-1, keepdims=True) + RMS_EPS)
    return (y * g.astype(jnp.float32)).astype(x.dtype)


def t5_bucket(dist):
    n = jnp.maximum(dist, 0)
    max_exact = REL_BUCKETS // 2
    nf = jnp.maximum(n, 1).astype(jnp.float32)
    large = max_exact + (jnp.log(nf / max_exact) / math.log(REL_MAX_DIST / max_exact)
                         * (REL_BUCKETS - max_exact)).astype(jnp.int32)
    large = jnp.minimum(large, REL_BUCKETS - 1)
    return jnp.where(n < max_exact, n, large)


def masked_softmax(logits, mask):
    p = jax.nn.softmax(jnp.where(mask, logits, NEG), axis=-1)
    return jnp.where(mask, p, 0.0)


def short_conv_mixer(u_b, u_c, u_x, conv_w):
    s = u_x.shape[1]
    v = u_c * u_x
    vp = jnp.pad(v, ((0, 0), (CONV_WIDTH - 1, 0), (0, 0)))
    conv = vp[:, 0:s] * conv_w[0]
    for k in range(1, CONV_WIDTH):
        conv = conv + vp[:, k:k + s] * conv_w[k]
    return u_b * conv


def memory_attention(xq, mem_n, w_mem_kv):
    b, s, _ = xq.shape
    m = mem_n.shape[1]
    kv = mem_n @ w_mem_kv
    k = kv[..., :XATTN_WIDTH].reshape(b, m, XATTN_HEADS, XATTN_HEAD_DIM)
    v = kv[..., XATTN_WIDTH:].reshape(b, m, XATTN_HEADS, XATTN_HEAD_DIM)
    q = xq.reshape(b, s, XATTN_HEADS, XATTN_HEAD_DIM)
    logits = jnp.einsum('bshd,bmhd->bhsm', q, k).astype(jnp.float32) * (XATTN_HEAD_DIM ** -0.5)
    p = jax.nn.softmax(logits, axis=-1).astype(v.dtype)
    o = jnp.einsum('bhsm,bmhd->bshd', p, v)
    return o.reshape(b, s, XATTN_WIDTH)


def nsa_mixer(proj, cmp_pos_k, cmp_w1_k, cmp_w2_k, cmp_pos_v, cmp_w1_v, cmp_w2_v, rel_bias):
    b, s, _ = proj.shape
    H, G, HPG, DK = NSA_HEADS, NSA_KV_GROUPS, NSA_HPG, NSA_HEAD_DIM
    qw = H * DK
    kvw = G * DK
    q = proj[..., :qw].reshape(b, s, G, HPG, DK).transpose(0, 2, 3, 1, 4)
    kv = proj[..., qw:qw + 6 * kvw].reshape(b, s, 6, G, DK).transpose(2, 0, 3, 1, 4)
    gates = jax.nn.sigmoid(proj[..., qw + 6 * kvw:].astype(jnp.float32)).reshape(b, s, 3, H)
    k_cmp_raw, v_cmp_raw, k_slc, v_slc, k_win, v_win = kv[0], kv[1], kv[2], kv[3], kv[4], kv[5]

    n_cmp = (s - CMP_BLOCK) // CMP_STRIDE + 1
    cmp_start = jnp.arange(n_cmp) * CMP_STRIDE
    cmp_idx = cmp_start[:, None] + jnp.arange(CMP_BLOCK)[None, :]

    def compress(raw, pos, w1, w2):
        blocks = raw[:, :, cmp_idx] + pos
        hmid = jax.nn.silu(blocks.reshape(b, G, n_cmp, CMP_BLOCK * DK) @ w1)
        return hmid @ w2

    k_cmp = compress(k_cmp_raw, cmp_pos_k, cmp_w1_k, cmp_w2_k)
    v_cmp = compress(v_cmp_raw, cmp_pos_v, cmp_w1_v, cmp_w2_v)
    cmp_last = cmp_start + CMP_BLOCK - 1

    n_sel = s // SEL_BLOCK
    top_k = min(SEL_TOPK, n_sel)
    sel_start = jnp.arange(n_sel) * SEL_BLOCK
    overlap = jnp.clip(jnp.minimum(cmp_start[:, None] + CMP_BLOCK, sel_start[None, :] + SEL_BLOCK)
                       - jnp.maximum(cmp_start[:, None], sel_start[None, :]), 0, None)
    overlap = overlap.astype(jnp.float32) / CMP_BLOCK

    bias_tab = rel_bias.astype(jnp.float32).T.reshape(G, HPG, REL_BUCKETS)
    g_ix = jnp.arange(G)[None, :, None, None, None]
    h_ix = jnp.arange(HPG)[None, None, :, None, None]
    k_win_p = jnp.pad(k_win, ((0, 0), (0, 0), (WINDOW, 0), (0, 0)))
    v_win_p = jnp.pad(v_win, ((0, 0), (0, 0), (WINDOW, 0), (0, 0)))
    band = WINDOW + Q_BLOCK
    scale = DK ** -0.5
    gather_rows = jax.vmap(jax.vmap(lambda a, i: a[i]))
    sel_offsets = jnp.arange(SEL_BLOCK)
    sel_ids = jnp.arange(n_sel)

    def block_fn(c):
        q0 = c * Q_BLOCK
        qb = lax.dynamic_slice_in_dim(q, q0, Q_BLOCK, axis=3)
        t = q0 + jnp.arange(Q_BLOCK)

        d_cmp = t[:, None] - cmp_last[None, :]
        lg = (jnp.einsum('bghqd,bgcd->bghqc', qb, k_cmp).astype(jnp.float32) * scale
              + bias_tab[:, :, t5_bucket(d_cmp)])
        p_cmp = masked_softmax(lg, d_cmp >= 0)
        o_cmp = jnp.einsum('bghqc,bgcd->bghqd', p_cmp.astype(v_cmp.dtype), v_cmp)

        imp = jnp.einsum('bghqc,cj->bgqj', p_cmp, overlap)
        cur = t // SEL_BLOCK
        forced = ((sel_ids[None, :] == 0) | (sel_ids[None, :] == cur[:, None])
                  | (sel_ids[None, :] == cur[:, None] - 1))
        valid = sel_start[None, :] <= t[:, None]
        imp = jnp.where(forced, SEL_FORCE, jnp.where(valid, imp, -SEL_FORCE))
        _, sel_idx = lax.top_k(imp, top_k)
        tok = (sel_idx[..., None] * SEL_BLOCK + sel_offsets).reshape(b, G, Q_BLOCK, top_k * SEL_BLOCK)
        k_s = gather_rows(k_slc, tok)
        v_s = gather_rows(v_slc, tok)
        d_s = t[None, None, :, None] - tok
        bias_s = bias_tab[g_ix, h_ix, t5_bucket(d_s)[:, :, None]]
        lg = jnp.einsum('bghqd,bgqtd->bghqt', qb, k_s).astype(jnp.float32) * scale + bias_s
        p_s = masked_softmax(lg, (d_s >= 0)[:, :, None])
        o_slc = jnp.einsum('bghqt,bgqtd->bghqd', p_s.astype(v_s.dtype), v_s)

        k_w = lax.dynamic_slice_in_dim(k_win_p, q0, band, axis=2)
        v_w = lax.dynamic_slice_in_dim(v_win_p, q0, band, axis=2)
        pos = q0 - WINDOW + jnp.arange(band)
        d_w = t[:, None] - pos[None, :]
        mask_w = (d_w >= 0) & (d_w < WINDOW) & (pos[None, :] >= 0)
        lg = (jnp.einsum('bghqd,bgkd->bghqk', qb, k_w).astype(jnp.float32) * scale
              + bias_tab[:, :, t5_bucket(d_w)])
        p_w = masked_softmax(lg, mask_w)
        o_win = jnp.einsum('bghqk,bgkd->bghqd', p_w.astype(v_w.dtype), v_w)
        return jnp.stack([o_cmp, o_slc, o_win], axis=0)

    outs = lax.map(block_fn, jnp.arange(s // Q_BLOCK))
    outs = outs.transpose(2, 0, 5, 1, 3, 4, 6).reshape(b, s, 3, H, DK)
    o = jnp.sum(gates[..., None].astype(outs.dtype) * outs, axis=2)
    return o.reshape(b, s, H * DK)


def setup_inputs(seed: int = 0) -> dict:
    key = jax.random.key(seed)
    ks = jax.random.split(key, 24)
    nrm = lambda k, shape, fan_in: jax.random.normal(k, shape, jnp.float32) * (fan_in ** -0.5)
    gain = lambda k, shape: 1.0 + 0.1 * jax.random.normal(k, shape, jnp.float32)
    return {
        "x": jax.random.normal(ks[0], (BATCH, SEQ, D_MODEL), jnp.float32),
        "mem": jax.random.normal(ks[1], (BATCH, N_MEM, D_MODEL), jnp.float32),
        "norm_mix_g": gain(ks[2], (DEPTH, D_MODEL)),
        "norm_mem_g": gain(ks[3], (DEPTH, D_MODEL)),
        "norm_ffn_g": gain(ks[4], (DEPTH, D_MODEL)),
        "norm_final_g": gain(ks[5], (D_MODEL,)),
        "w_in_conv": nrm(ks[6], (N_CONV_LAYERS, D_MODEL, CONV_IN_WIDTH), D_MODEL),
        "conv_w": nrm(ks[7], (N_CONV_LAYERS, CONV_WIDTH, D_MODEL), CONV_WIDTH),
        "w_in_nsa": nrm(ks[8], (N_NSA_LAYERS, D_MODEL, NSA_IN_WIDTH), D_MODEL),
        "cmp_pos_k": 0.1 * jax.random.normal(ks[9], (N_NSA_LAYERS, CMP_BLOCK, NSA_HEAD_DIM), jnp.float32),
        "cmp_w1_k": nrm(ks[10], (N_NSA_LAYERS, CMP_BLOCK * NSA_HEAD_DIM, CMP_HIDDEN), CMP_BLOCK * NSA_HEAD_DIM),
        "cmp_w2_k": nrm(ks[11], (N_NSA_LAYERS, CMP_HIDDEN, NSA_HEAD_DIM), CMP_HIDDEN),
        "cmp_pos_v": 0.1 * jax.random.normal(ks[12], (N_NSA_LAYERS, CMP_BLOCK, NSA_HEAD_DIM), jnp.float32),
        "cmp_w1_v": nrm(ks[13], (N_NSA_LAYERS, CMP_BLOCK * NSA_HEAD_DIM, CMP_HIDDEN), CMP_BLOCK * NSA_HEAD_DIM),
        "cmp_w2_v": nrm(ks[14], (N_NSA_LAYERS, CMP_HIDDEN, NSA_HEAD_DIM), CMP_HIDDEN),
        "rel_bias": 0.5 * jax.random.normal(ks[15], (REL_BUCKETS, NSA_HEADS), jnp.float32),
        "w_mem_kv": nrm(ks[16], (DEPTH, D_MODEL, 2 * XATTN_WIDTH), D_MODEL),
        "w_out": nrm(ks[17], (DEPTH, MIX_WIDTH, D_MODEL), MIX_WIDTH),
        "w_ffn_in": nrm(ks[18], (DEPTH, D_MODEL, 2 * FFN_HIDDEN), D_MODEL),
        "w_ffn_out": nrm(ks[19], (DEPTH, FFN_HIDDEN, D_MODEL), FFN_HIDDEN),
    }


def reference(x, mem, norm_mix_g, norm_mem_g, norm_ffn_g, norm_final_g, w_in_conv, conv_w,
              w_in_nsa, cmp_pos_k, cmp_w1_k, cmp_w2_k, cmp_pos_v, cmp_w1_v, cmp_w2_v, rel_bias,
              w_mem_kv, w_out, w_ffn_in, w_ffn_out):
    h = x
    for i in range(DEPTH):
        a = i // N_MIXERS
        hn = rmsnorm(h, norm_mix_g[i])
        mem_n = rmsnorm(mem, norm_mem_g[i])
        if i % N_MIXERS == 0:
            proj = hn @ w_in_conv[a]
            tok = short_conv_mixer(proj[..., :D_MODEL], proj[..., D_MODEL:2 * D_MODEL],
                                   proj[..., 2 * D_MODEL:3 * D_MODEL], conv_w[a])
            xq = proj[..., 3 * D_MODEL:]
        else:
            proj = hn @ w_in_nsa[a]
            tok = nsa_mixer(proj[..., :NSA_IN_WIDTH - XATTN_WIDTH], cmp_pos_k[a], cmp_w1_k[a],
                            cmp_w2_k[a], cmp_pos_v[a], cmp_w1_v[a], cmp_w2_v[a], rel_bias)
            xq = proj[..., NSA_IN_WIDTH - XATTN_WIDTH:]
        mo = memory_attention(xq, mem_n, w_mem_kv[i])
        h = h + jnp.concatenate([tok, mo], axis=-1) @ w_out[i]
        hn = rmsnorm(h, norm_ffn_g[i])
        gu = hn @ w_ffn_in[i]
        h = h + (jax.nn.silu(gu[..., :FFN_HIDDEN]) * gu[..., FFN_HIDDEN:]) @ w_ffn_out[i]
    return rmsnorm(h, norm_final_g)
```

```cpp
#include <hip/hip_runtime.h>
#include <stdint.h>

typedef unsigned short bf16_t;
typedef short bf16x8 __attribute__((ext_vector_type(8)));
typedef float f32x4 __attribute__((ext_vector_type(4)));

namespace nv {
constexpr int BATCH = 2, SEQ = 8192, DM = 1024, MTOK = BATCH * SEQ, NMEM = 256;
constexpr int FFH = 2816, CONV_IN = 3584, NSA_IN = 3120, MIXW = 1536, XW = 512;
constexpr int NCMP = 511;
constexpr float RMS_EPS = 1e-6f;

__device__ __forceinline__ float bf2f(bf16_t v) { return __uint_as_float((unsigned)v << 16); }
__device__ __forceinline__ bf16_t f2bf(float f) { unsigned u = __float_as_uint(f); return (bf16_t)((u + 0x7fffu + ((u >> 16) & 1u)) >> 16); }

__device__ const unsigned char T5TAB[128] = {0, 1, 2, 3, 4, 5, 6, 7, 8, 9, 10, 11, 12, 13, 14, 15, 16, 16, 16, 17, 17, 18, 18, 18, 19, 19, 19, 20, 20, 20, 20, 21, 21, 21, 21, 22, 22, 22, 22, 22, 23, 23, 23, 23, 23, 23, 24, 24, 24, 24, 24, 24, 25, 25, 25, 25, 25, 25, 25, 26, 26, 26, 26, 26, 26, 26, 26, 27, 27, 27, 27, 27, 27, 27, 27, 27, 27, 28, 28, 28, 28, 28, 28, 28, 28, 28, 28, 29, 29, 29, 29, 29, 29, 29, 29, 29, 29, 29, 29, 30, 30, 30, 30, 30, 30, 30, 30, 30, 30, 30, 30, 30, 30, 31, 31, 31, 31, 31, 31, 31, 31, 31, 31, 31, 31, 31, 31, 31};
__device__ __forceinline__ int t5b(int d) { return d >= 113 ? 31 : (int)T5TAB[d < 0 ? 0 : d]; }

__device__ __forceinline__ float wave_sum(float v) {
#pragma unroll
    for (int o = 1; o < 64; o <<= 1) v += __shfl_xor(v, o);
    return v;
}
__device__ __forceinline__ float wave_max(float v) {
#pragma unroll
    for (int o = 1; o < 64; o <<= 1) v = fmaxf(v, __shfl_xor(v, o));
    return v;
}

__global__ void rms_rows(const float* __restrict__ x, const float* __restrict__ g, bf16_t* __restrict__ out, int rows) {
    const int row = blockIdx.x * 4 + (threadIdx.x >> 6), lane = threadIdx.x & 63;
    if (row >= rows) return;
    const f32x4* xr = (const f32x4*)(x + (size_t)row * DM);
    f32x4 v[4]; float s = 0.f;
#pragma unroll
    for (int j = 0; j < 4; ++j) { v[j] = xr[lane + 64 * j]; s += v[j].x * v[j].x + v[j].y * v[j].y + v[j].z * v[j].z + v[j].w * v[j].w; }
    const float r = rsqrtf(wave_sum(s) * (1.f / DM) + RMS_EPS);
#pragma unroll
    for (int j = 0; j < 4; ++j) {
        const f32x4 gg = ((const f32x4*)g)[lane + 64 * j];
        bf16_t* o = out + (size_t)row * DM + 4 * (lane + 64 * j);
        o[0] = f2bf(v[j].x * r * gg.x); o[1] = f2bf(v[j].y * r * gg.y); o[2] = f2bf(v[j].z * r * gg.z); o[3] = f2bf(v[j].w * r * gg.w);
    }
}
__global__ void rms_final(float* __restrict__ x, const float* __restrict__ g, int rows) {
    const int row = blockIdx.x * 4 + (threadIdx.x >> 6), lane = threadIdx.x & 63;
    if (row >= rows) return;
    f32x4* xr = (f32x4*)(x + (size_t)row * DM);
    f32x4 v[4]; float s = 0.f;
#pragma unroll
    for (int j = 0; j < 4; ++j) { v[j] = xr[lane + 64 * j]; s += v[j].x * v[j].x + v[j].y * v[j].y + v[j].z * v[j].z + v[j].w * v[j].w; }
    const float r = rsqrtf(wave_sum(s) * (1.f / DM) + RMS_EPS);
#pragma unroll
    for (int j = 0; j < 4; ++j) { const f32x4 gg = ((const f32x4*)g)[lane + 64 * j]; xr[lane + 64 * j] = v[j] * r * gg; }
}

template <int MODE>
__global__ void __launch_bounds__(256) gemm_naive(const bf16_t* __restrict__ A, int lda, const float* __restrict__ W, int ldw, int M, int N, int K, void* __restrict__ Cv, int ldc, int dual) {
    const int lane = threadIdx.x & 63, w = threadIdx.x >> 6, fr = lane & 15, fq = lane >> 4;
    const int row0 = blockIdx.y * 64 + w * 16, col0 = blockIdx.x * 64;
    f32x4 acc[4], acc2[4];
#pragma unroll
    for (int c = 0; c < 4; ++c) { acc[c] = (f32x4){0.f, 0.f, 0.f, 0.f}; acc2[c] = (f32x4){0.f, 0.f, 0.f, 0.f}; }
    const bf16_t* ap = A + (size_t)(row0 + fr) * lda + 8 * fq;
    for (int k0 = 0; k0 < K; k0 += 32) {
        const bf16x8 a = *(const bf16x8*)(ap + k0);
#pragma unroll
        for (int c = 0; c < 4; ++c) {
            const int col = col0 + 16 * c + fr; const bool ok = col < N;
            bf16x8 b, b2;
#pragma unroll
            for (int j = 0; j < 8; ++j) {
                const float* wp = W + (size_t)(k0 + 8 * fq + j) * ldw + col;
                b[j] = (short)f2bf(ok ? wp[0] : 0.f);
                if (MODE == 2) b2[j] = (short)f2bf(ok ? wp[dual] : 0.f);
            }
            acc[c] = __builtin_amdgcn_mfma_f32_16x16x32_bf16(a, b, acc[c], 0, 0, 0);
            if (MODE == 2) acc2[c] = __builtin_amdgcn_mfma_f32_16x16x32_bf16(a, b2, acc2[c], 0, 0, 0);
        }
    }
#pragma unroll
    for (int c = 0; c < 4; ++c) {
        const int col = col0 + 16 * c + fr; if (col >= N) continue;
#pragma unroll
        for (int r = 0; r < 4; ++r) {
            const int row = row0 + fq * 4 + r; const size_t off = (size_t)row * ldc + col;
            if (MODE == 0) ((bf16_t*)Cv)[off] = f2bf(acc[c][r]);
            else if (MODE == 1) ((float*)Cv)[off] += acc[c][r];
            else { const float g = acc[c][r], u = acc2[c][r]; ((bf16_t*)Cv)[off] = f2bf(g / (1.f + __expf(-g)) * u); }
        }
    }
}

__global__ void conv_mix(const bf16_t* __restrict__ P, const float* __restrict__ cw, bf16_t* __restrict__ MIX) {
    const int idx = blockIdx.x * 256 + threadIdx.x; const int t = idx >> 10, c = idx & 1023;
    const int tl = t & (SEQ - 1);
    float conv = 0.f;
#pragma unroll
    for (int k = 0; k < 3; ++k) {
        const int back = 2 - k;
        if (tl - back >= 0) { const bf16_t* pr = P + (size_t)(t - back) * CONV_IN; conv += cw[k * DM + c] * (bf2f(pr[DM + c]) * bf2f(pr[2 * DM + c])); }
    }
    MIX[(size_t)t * MIXW + c] = f2bf(bf2f(P[(size_t)t * CONV_IN + c]) * conv);
}

__global__ void __launch_bounds__(256) mem_attn(const bf16_t* __restrict__ XQ, int ldq, const bf16_t* __restrict__ KVM, bf16_t* __restrict__ MIX) {
    __shared__ float qs[4][128]; __shared__ float ps[4][256];
    const int t = blockIdx.x, b = t / SEQ, h = threadIdx.x >> 6, lane = threadIdx.x & 63;
    const bf16_t* q = XQ + (size_t)t * ldq + h * 128;
    qs[h][lane] = bf2f(q[lane]); qs[h][lane + 64] = bf2f(q[lane + 64]);
    __syncthreads();
    float lg[4]; float mx = -3.0e38f;
#pragma unroll
    for (int i = 0; i < 4; ++i) {
        const int key = lane + 64 * i; const bf16_t* kr = KVM + (size_t)(b * NMEM + key) * 1024 + h * 128;
        float s = 0.f;
        for (int d = 0; d < 128; d += 8) { const bf16x8 kv = *(const bf16x8*)(kr + d);
#pragma unroll
            for (int j = 0; j < 8; ++j) s += qs[h][d + j] * bf2f((bf16_t)kv[j]); }
        lg[i] = s * 0.08838834764831845f; mx = fmaxf(mx, lg[i]);
    }
    mx = wave_max(mx); float sum = 0.f;
#pragma unroll
    for (int i = 0; i < 4; ++i) { lg[i] = __expf(lg[i] - mx); sum += lg[i]; }
    sum = wave_sum(sum); const float inv = 1.f / sum;
#pragma unroll
    for (int i = 0; i < 4; ++i) ps[h][lane + 64 * i] = lg[i] * inv;
    __syncthreads();
    float o0 = 0.f, o1 = 0.f;
    for (int key = 0; key < 256; ++key) { const bf16_t* vr = KVM + (size_t)(b * NMEM + key) * 1024 + 512 + h * 128 + 2 * lane; const float p = ps[h][key]; o0 += p * bf2f(vr[0]); o1 += p * bf2f(vr[1]); }
    bf16_t* o = MIX + (size_t)t * MIXW + 1024 + h * 128 + 2 * lane; o[0] = f2bf(o0); o[1] = f2bf(o1);
}

__global__ void __launch_bounds__(128) cmp_mlp(const bf16_t* __restrict__ P, const float* __restrict__ posk, const float* __restrict__ w1k, const float* __restrict__ w2k,
                                               const float* __restrict__ posv, const float* __restrict__ w1v, const float* __restrict__ w2v, float* __restrict__ OUT) {
    __shared__ float xs[2048]; __shared__ float hm[128];
    const int c = blockIdx.x, bg = blockIdx.y, kv = blockIdx.z, b = bg >> 2, g = bg & 3, tid = threadIdx.x;
    const float* pos = kv ? posv : posk; const float* w1 = kv ? w1v : w1k; const float* w2 = kv ? w2v : w2k;
    for (int k = tid; k < 2048; k += 128) { const int i = k >> 6, d = k & 63; xs[k] = bf2f(P[(size_t)(b * SEQ + 16 * c + i) * NSA_IN + 1024 + kv * 256 + g * 64 + d]) + pos[k]; }
    __syncthreads();
    float acc = 0.f;
    for (int k = 0; k < 2048; ++k) acc += xs[k] * w1[(size_t)k * 128 + tid];
    hm[tid] = acc / (1.f + __expf(-acc));
    __syncthreads();
    if (tid < 64) { float o = 0.f; for (int n = 0; n < 128; ++n) o += hm[n] * w2[n * 64 + tid]; OUT[((size_t)(kv * 8 + bg) * 512 + c) * 64 + tid] = o; }
}

__global__ void __launch_bounds__(256) nsa_naive(const bf16_t* __restrict__ P, const float* __restrict__ CMP, const float* __restrict__ relb, bf16_t* __restrict__ MIX) {
    __shared__ float qs[4][64]; __shared__ float ps[4][1024]; __shared__ float impS[128]; __shared__ int sel[16];
    const int tl = blockIdx.x, g = blockIdx.y, b = blockIdx.z, j = threadIdx.x >> 6, lane = threadIdx.x & 63, h = g * 4 + j, bg = b * 4 + g;
    const size_t rowb = (size_t)b * SEQ; const int t = tl;
    const bf16_t* prow = P + (rowb + t) * NSA_IN;
    qs[j][lane] = bf2f(prow[h * 64 + lane]) * 0.125f;
    const float* KC = CMP + (size_t)bg * 512 * 64; const float* VC = CMP + (size_t)(8 + bg) * 512 * 64;
    __syncthreads();
    const int ncmp = t >= 31 ? (t - 31) / 16 + 1 : 0;
    float lg[16]; float mx = -3.0e38f;
#pragma unroll
    for (int i = 0; i < 8; ++i) {
        const int c = lane + 64 * i; lg[i] = -3.0e38f;
        if (c < ncmp) { const float* kr = KC + (size_t)c * 64; float s = 0.f;
            for (int d = 0; d < 64; d += 4) { const f32x4 kv = *(const f32x4*)(kr + d); s += qs[j][d] * kv.x + qs[j][d + 1] * kv.y + qs[j][d + 2] * kv.z + qs[j][d + 3] * kv.w; }
            lg[i] = s + relb[t5b(t - 16 * c - 31) * 16 + h]; }
        mx = fmaxf(mx, lg[i]);
    }
    mx = wave_max(mx); float sum = 0.f;
#pragma unroll
    for (int i = 0; i < 8; ++i) { const int c = lane + 64 * i; lg[i] = c < ncmp ? __expf(lg[i] - mx) : 0.f; sum += lg[i]; }
    sum = wave_sum(sum); const float inv = ncmp > 0 ? 1.f / sum : 0.f;
#pragma unroll
    for (int i = 0; i < 8; ++i) ps[j][lane + 64 * i] = lg[i] * inv;
    __syncthreads();
    float o_cmp = 0.f;
    for (int c = 0; c < ncmp; ++c) o_cmp += ps[j][c] * VC[(size_t)c * 64 + lane];
    const int cur = t >> 6;
    if (threadIdx.x < 128) {
        const int jj = threadIdx.x; float im = 0.f;
#pragma unroll
        for (int hh = 0; hh < 4; ++hh) {
            const float* pp = ps[hh]; const int c0 = 4 * jj;
            float a = pp[c0] + pp[c0 + 1] + pp[c0 + 2];
            if (c0 + 3 < NCMP) a += 0.5f * pp[c0 + 3];
            if (c0 >= 1) a += 0.5f * pp[c0 - 1];
            im += a;
        }
        const bool forced = (jj == 0) || (jj == cur) || (jj == cur - 1); const bool valid = jj <= cur;
        impS[jj] = forced ? 1.0e4f : (valid ? im : -1.0e4f);
    }
    __syncthreads();
    if (j == 0) {
        float a = impS[lane], bb = impS[lane + 64];
        for (int it = 0; it < 16; ++it) {
            const float m = wave_max(fmaxf(a, bb));
            unsigned long long ba = __ballot(a == m);
            int idx;
            if (ba) { idx = __ffsll((long long)ba) - 1; if (lane == idx) a = -INFINITY; }
            else { unsigned long long b2 = __ballot(bb == m); idx = __ffsll((long long)b2) - 1; if (lane == idx) bb = -INFINITY; idx += 64; }
            if (lane == 0) sel[it] = idx;
        }
    }
    __syncthreads();
    const bf16_t* Pb = P + rowb * NSA_IN;
    mx = -3.0e38f;
#pragma unroll
    for (int i = 0; i < 16; ++i) {
        const int tok = sel[i] * 64 + lane; lg[i] = -3.0e38f;
        if (tok <= t) { const bf16_t* kr = Pb + (size_t)tok * NSA_IN + 1024 + 2 * 256 + g * 64; float s = 0.f;
            for (int d = 0; d < 64; d += 8) { const bf16x8 kv = *(const bf16x8*)(kr + d);
#pragma unroll
                for (int e = 0; e < 8; ++e) s += qs[j][d + e] * bf2f((bf16_t)kv[e]); }
            lg[i] = s + relb[t5b(t - tok) * 16 + h]; }
        mx = fmaxf(mx, lg[i]);
    }
    mx = wave_max(mx); sum = 0.f;
#pragma unroll
    for (int i = 0; i < 16; ++i) { const int tok = sel[i] * 64 + lane; lg[i] = tok <= t ? __expf(lg[i] - mx) : 0.f; sum += lg[i]; }
    sum = wave_sum(sum); { const float iv = 1.f / sum;
#pragma unroll
    for (int i = 0; i < 16; ++i) ps[j][i * 64 + lane] = lg[i] * iv; }
    __syncthreads();
    float o_slc = 0.f;
    for (int i = 0; i < 16; ++i) { const int base = sel[i] * 64; if (base > t) continue;
        for (int n = 0; n < 64; ++n) { const int tok = base + n; if (tok > t) break; o_slc += ps[j][i * 64 + n] * bf2f(Pb[(size_t)tok * NSA_IN + 1024 + 3 * 256 + g * 64 + lane]); } }
    __syncthreads();
    mx = -3.0e38f;
#pragma unroll
    for (int i = 0; i < 8; ++i) {
        const int pos = t - 511 + lane + 64 * i; lg[i] = -3.0e38f;
        if (pos >= 0) { const bf16_t* kr = Pb + (size_t)pos * NSA_IN + 1024 + 4 * 256 + g * 64; float s = 0.f;
            for (int d = 0; d < 64; d += 8) { const bf16x8 kv = *(const bf16x8*)(kr + d);
#pragma unroll
                for (int e = 0; e < 8; ++e) s += qs[j][d + e] * bf2f((bf16_t)kv[e]); }
            lg[i] = s + relb[t5b(t - pos) * 16 + h]; }
        mx = fmaxf(mx, lg[i]);
    }
    mx = wave_max(mx); sum = 0.f;
#pragma unroll
    for (int i = 0; i < 8; ++i) { const int pos = t - 511 + lane + 64 * i; lg[i] = pos >= 0 ? __expf(lg[i] - mx) : 0.f; sum += lg[i]; }
    sum = wave_sum(sum); { const float iv = 1.f / sum;
#pragma unroll
    for (int i = 0; i < 8; ++i) ps[j][lane + 64 * i] = lg[i] * iv; }
    __syncthreads();
    float o_win = 0.f;
    for (int n = 0; n < 512; ++n) { const int pos = t - 511 + n; if (pos < 0) continue; o_win += ps[j][n] * bf2f(Pb[(size_t)pos * NSA_IN + 1024 + 5 * 256 + g * 64 + lane]); }
    const float gc = 1.f / (1.f + __expf(-bf2f(prow[2560 + h]))), gs = 1.f / (1.f + __expf(-bf2f(prow[2560 + 16 + h]))), gw = 1.f / (1.f + __expf(-bf2f(prow[2560 + 32 + h])));
    MIX[(rowb + t) * MIXW + h * 64 + lane] = f2bf(gc * o_cmp + gs * o_slc + gw * o_win);
}

struct Ws { bf16_t* XN; bf16_t* MEMN; bf16_t* KVM; bf16_t* MIX; bf16_t* PROJ; bf16_t* HID; float* CMP; };

static void forward(void* const* d_in, float* h, void* d_ws, hipStream_t st) {
    const float* x = (const float*)d_in[0]; const float* mem = (const float*)d_in[1];
    const float* g_mix = (const float*)d_in[2]; const float* g_mem = (const float*)d_in[3]; const float* g_ffn = (const float*)d_in[4]; const float* g_fin = (const float*)d_in[5];
    const float* w_in_conv = (const float*)d_in[6]; const float* conv_w = (const float*)d_in[7]; const float* w_in_nsa = (const float*)d_in[8];
    const float* posk = (const float*)d_in[9]; const float* w1k = (const float*)d_in[10]; const float* w2k = (const float*)d_in[11];
    const float* posv = (const float*)d_in[12]; const float* w1v = (const float*)d_in[13]; const float* w2v = (const float*)d_in[14];
    const float* relb = (const float*)d_in[15]; const float* w_mem_kv = (const float*)d_in[16]; const float* w_out = (const float*)d_in[17];
    const float* w_ffn_in = (const float*)d_in[18]; const float* w_ffn_out = (const float*)d_in[19];
    char* ws = (char*)d_ws; const size_t MiB = 1u << 20;
    Ws W; W.XN = (bf16_t*)(ws + 0); W.MIX = (bf16_t*)(ws + 32 * MiB); W.PROJ = (bf16_t*)(ws + 80 * MiB); W.HID = W.PROJ;
    W.MEMN = (bf16_t*)(ws + 200 * MiB); W.KVM = (bf16_t*)(ws + 202 * MiB); W.CMP = (float*)(ws + 204 * MiB);
    hipMemcpyAsync(h, x, (size_t)MTOK * DM * 4, hipMemcpyDeviceToDevice, st);
    for (int i = 0; i < 2; ++i) {
        rms_rows<<<MTOK / 4, 256, 0, st>>>(h, g_mix + i * DM, W.XN, MTOK);
        rms_rows<<<BATCH * NMEM / 4, 256, 0, st>>>(mem, g_mem + i * DM, W.MEMN, BATCH * NMEM);
        gemm_naive<0><<<dim3(1024 / 64, BATCH * NMEM / 64), 256, 0, st>>>(W.MEMN, DM, w_mem_kv + (size_t)i * DM * 1024, 1024, BATCH * NMEM, 1024, DM, W.KVM, 1024, 0);
        const bf16_t* xq; int ldq;
        if (i == 0) {
            gemm_naive<0><<<dim3(CONV_IN / 64, MTOK / 64), 256, 0, st>>>(W.XN, DM, w_in_conv, CONV_IN, MTOK, CONV_IN, DM, W.PROJ, CONV_IN, 0);
            conv_mix<<<MTOK * DM / 256, 256, 0, st>>>(W.PROJ, conv_w, W.MIX);
            xq = W.PROJ + 3 * DM; ldq = CONV_IN;
        } else {
            gemm_naive<0><<<dim3((NSA_IN + 63) / 64, MTOK / 64), 256, 0, st>>>(W.XN, DM, w_in_nsa, NSA_IN, MTOK, NSA_IN, DM, W.PROJ, NSA_IN, 0);
            cmp_mlp<<<dim3(NCMP, 8, 2), 128, 0, st>>>(W.PROJ, posk, w1k, w2k, posv, w1v, w2v, W.CMP);
            nsa_naive<<<dim3(SEQ, 4, BATCH), 256, 0, st>>>(W.PROJ, W.CMP, relb, W.MIX);
            xq = W.PROJ + 2608; ldq = NSA_IN;
        }
        mem_attn<<<MTOK, 256, 0, st>>>(xq, ldq, W.KVM, W.MIX);
        gemm_naive<1><<<dim3(DM / 64, MTOK / 64), 256, 0, st>>>(W.MIX, MIXW, w_out + (size_t)i * MIXW * DM, DM, MTOK, DM, MIXW, h, DM, 0);
        rms_rows<<<MTOK / 4, 256, 0, st>>>(h, g_ffn + i * DM, W.XN, MTOK);
        gemm_naive<2><<<dim3(FFH / 64, MTOK / 64), 256, 0, st>>>(W.XN, DM, w_ffn_in + (size_t)i * DM * 2 * FFH, 2 * FFH, MTOK, FFH, DM, W.HID, FFH, FFH);
        gemm_naive<1><<<dim3(DM / 64, MTOK / 64), 256, 0, st>>>(W.HID, FFH, w_ffn_out + (size_t)i * FFH * DM, DM, MTOK, DM, FFH, h, DM, 0);
    }
    rms_final<<<MTOK / 4, 256, 0, st>>>(h, g_fin, MTOK);
}
}

extern "C" void kernel_launch(void* const* d_in, const int* in_sizes, int n_in, void* d_out, int out_size, void* d_ws, size_t ws_size, hipStream_t stream) {
    nv::forward(d_in, (float*)d_out, d_ws, stream);
}
```

```cpp
#include <hip/hip_runtime.h>
#include <cstdio>
#include <cstdint>
#include <cmath>

namespace pg8 {
#define PG8_LAS __attribute__((address_space(3)))
typedef unsigned short bf16_t;
typedef short bf16x8 __attribute__((ext_vector_type(8)));
typedef float f32x4 __attribute__((ext_vector_type(4)));
typedef unsigned u32x4 __attribute__((ext_vector_type(4)));
constexpr int BM = 256, BK = 64, HALF = 128, HTB = HALF * BK * 2  , STAGE_BYTES = 8 * HTB, NXCD = 8, WGM = 8;

__host__ __device__ __forceinline__ int lds_byte(int r, int c) { const int st = (r >> 4) * 2 + (c >> 5), rr = r & 15, cc = c & 31, ob = rr * 64 + cc * 2; return st * 1024 + (ob ^ (((ob >> 9) & 1) << 5)); }
__host__ __device__ __forceinline__ void stage_rc(int b, int& R, int& C) { const int st = b / 1024, sb = b % 1024, swz = sb ^ (((sb >> 9) & 1) << 5); R = (st >> 1) * 16 + swz / 64; C = (st & 1) * 32 + (swz % 64) / 2; }
__host__ __device__ __forceinline__ int perm32(int rho) { const int n = rho >> 4, i = rho & 15; return 8 * (i >> 2) + 4 * n + (i & 3); }

struct Unit { int pm, pn; };
struct Gemm { const bf16_t* A; const bf16_t* Bt; int M, N, K, lda; };

struct StaticOrder {
    int nM, nN, nwg, G, c;
    __host__ __device__ void init(int M, int N, int G_, int c_) { nM = M / BM; nN = N / BM; nwg = nM * nN; G = G_; c = c_; }
    __host__ __device__ bool next(int i, Unit& u) const {
        const long L = (long)i * G + c; if (L >= nwg) return false;
        int wgid = (int)L; { const int q = nwg / NXCD, r = nwg % NXCD, xcd = wgid % NXCD, off = wgid / NXCD; wgid = (xcd < r ? xcd * (q + 1) : r * (q + 1) + (xcd - r) * q) + off; }
        const int nig = WGM * nN, gid = wgid / nig, fm = gid * WGM, gsz = (nM - fm) < WGM ? (nM - fm) : WGM;
        u.pm = fm + ((wgid % nig) % gsz); u.pn = (wgid % nig) / gsz; return true;
    }
    __device__ __forceinline__ void a_ready(const Unit&) const {}
    __device__ __forceinline__ void done(const Unit&) const {}
};


__device__ __forceinline__ unsigned cvt_pk_bf16(float lo, float hi) { unsigned r; asm volatile("v_cvt_pk_bf16_f32 %0, %1, %2" : "=v"(r) : "v"(lo), "v"(hi)); return r; }
__device__ __forceinline__ u32x4 pack8(const f32x4 v0, const f32x4 v1) { u32x4 w; w.x = cvt_pk_bf16(v0[0], v0[1]); w.y = cvt_pk_bf16(v0[2], v0[3]); w.z = cvt_pk_bf16(v1[0], v1[1]); w.w = cvt_pk_bf16(v1[2], v1[3]); return w; }
__device__ __forceinline__ float row_rstd(const float* __restrict__ stats, int row) {
    const f32x4* s = (const f32x4*)(stats + (size_t)row * 16);
    const f32x4 a = s[0], b = s[1], c = s[2], d = s[3];
    const float t = ((a[0] + a[1]) + (a[2] + a[3])) + ((b[0] + b[1]) + (b[2] + b[3])) + ((c[0] + c[1]) + (c[2] + c[3])) + ((d[0] + d[1]) + (d[2] + d[3]));
    return rsqrtf(t * (1.0f / 1024.0f) + 1e-6f);
}
__device__ __forceinline__ float silu_f(float g) { return g * __builtin_amdgcn_rcpf(1.0f + __builtin_amdgcn_exp2f(-1.4426950408889634f * g)); }
__device__ __forceinline__ float sigm_f(float g) { return __builtin_amdgcn_rcpf(1.0f + __builtin_amdgcn_exp2f(-1.4426950408889634f * g)); }

struct EpiMemKV {
    static constexpr bool PERM = true, AFTER_DRAIN = false;
    bf16_t* MK; bf16_t* MV;
    __device__ __forceinline__ void operator()(const f32x4 (&acc)[2][2][4][2], const Unit& u, int wr, int wc, int fr, int fq) const {
        const int la = u.pm >> 1, b = u.pm & 1, kv = (u.pn >> 1) & 1;
#pragma unroll
        for (int ai = 0; ai < 2; ++ai)
#pragma unroll
            for (int m = 0; m < 4; ++m) { const int key = ai * HALF + wr * 64 + m * 16 + fr;
#pragma unroll
                for (int bj = 0; bj < 2; ++bj) { const int head = (u.pn & 1) * 2 + bj, d = wc * 32 + 8 * fq;
                    bf16_t* base = (kv ? MV : MK) + (size_t)((la * 2 + b) * 4 + head) * 32768;
                    const size_t off = kv ? (size_t)(key >> 6) * 8192 + (d >> 5) * 2048 + (key & 63) * 32 + (d & 31) : (size_t)(key >> 6) * 8192 + (d >> 3) * 512 + (key & 63) * 8;
                    *(u32x4*)(base + off) = pack8(acc[ai][bj][m][0], acc[ai][bj][m][1]); } }
    }
};
struct DiagOrder {
    int G, c;
    __device__ bool next(int i, Unit& u) const { const int L = i * G + c; if (L >= 16) return false; const int la = L >> 3; u.pm = la * 2 + ((L >> 2) & 1); u.pn = la * 4 + (L & 3); return true; }
    __device__ __forceinline__ void a_ready(const Unit&) const {}
    __device__ __forceinline__ void done(const Unit&) const {}
};
struct EpiConv {
    static constexpr bool PERM = true, AFTER_DRAIN = false;
    bf16_t* UB; bf16_t* V; bf16_t* XQ; const float* stats;
    __device__ __forceinline__ void operator()(const f32x4 (&acc)[2][2][4][2], const Unit& u, int wr, int wc, int fr, int fq) const {
#pragma unroll
        for (int ai = 0; ai < 2; ++ai)
#pragma unroll
            for (int m = 0; m < 4; ++m) { const int row = u.pm * BM + ai * HALF + wr * 64 + m * 16 + fr; const float rs = row_rstd(stats, row);
                if (u.pn < 4) {
#pragma unroll
                    for (int bj = 0; bj < 2; ++bj) *(u32x4*)(UB + (size_t)row * 1024 + u.pn * BM + bj * HALF + wc * 32 + 8 * fq) = pack8(acc[ai][bj][m][0] * rs, acc[ai][bj][m][1] * rs);
                } else if (u.pn < 12) {
                    const float r2 = rs * rs;
                    *(u32x4*)(V + (size_t)row * 1024 + (u.pn - 4) * HALF + wc * 32 + 8 * fq) = pack8(acc[ai][0][m][0] * acc[ai][1][m][0] * r2, acc[ai][0][m][1] * acc[ai][1][m][1] * r2);
                } else {
#pragma unroll
                    for (int bj = 0; bj < 2; ++bj) *(u32x4*)(XQ + (size_t)row * 512 + (u.pn - 12) * BM + bj * HALF + wc * 32 + 8 * fq) = pack8(acc[ai][bj][m][0] * rs, acc[ai][bj][m][1] * rs);
                } }
    }
};
struct EpiSwiglu {
    static constexpr bool PERM = true, AFTER_DRAIN = false;
    bf16_t* HID; const float* stats;
    __device__ __forceinline__ void operator()(const f32x4 (&acc)[2][2][4][2], const Unit& u, int wr, int wc, int fr, int fq) const {
#pragma unroll
        for (int ai = 0; ai < 2; ++ai)
#pragma unroll
            for (int m = 0; m < 4; ++m) { const int row = u.pm * BM + ai * HALF + wr * 64 + m * 16 + fr; const float rs = row_rstd(stats, row);
                f32x4 o[2];
#pragma unroll
                for (int n = 0; n < 2; ++n)
#pragma unroll
                    for (int e = 0; e < 4; ++e) o[n][e] = silu_f(acc[ai][0][m][n][e] * rs) * (acc[ai][1][m][n][e] * rs);
                *(u32x4*)(HID + (size_t)row * 2816 + u.pn * HALF + wc * 32 + 8 * fq) = pack8(o[0], o[1]); }
    }
};
struct EpiNsa {
    static constexpr bool PERM = true, AFTER_DRAIN = false;
    bf16_t* Q; bf16_t* KV; bf16_t* XQ; float* GATES; const float* stats;
    __device__ __forceinline__ void operator()(const f32x4 (&acc)[2][2][4][2], const Unit& u, int wr, int wc, int fr, int fq) const {
#pragma unroll
        for (int ai = 0; ai < 2; ++ai)
#pragma unroll
            for (int m = 0; m < 4; ++m) { const int row = u.pm * BM + ai * HALF + wr * 64 + m * 16 + fr; const float rs = row_rstd(stats, row);
                if (u.pn < 4) {
#pragma unroll
                    for (int bj = 0; bj < 2; ++bj) *(u32x4*)(Q + (size_t)row * 1024 + u.pn * BM + bj * HALF + wc * 32 + 8 * fq) = pack8(acc[ai][bj][m][0] * rs, acc[ai][bj][m][1] * rs);
                } else if (u.pn < 10) {
                    const int b = row >> 13, s = row & 8191;
#pragma unroll
                    for (int bj = 0; bj < 2; ++bj) { const int ct = bj * HALF + wc * 32 + 8 * fq, g = ct >> 6, d = ct & 63, sl = u.pn - 4;
                        const size_t off = sl < 2 ? (size_t)s * 64 + d : ((sl & 1) ? (size_t)(s >> 6) * 4096 + (d >> 5) * 2048 + (s & 63) * 32 + (d & 31) : (size_t)(s >> 6) * 4096 + (d >> 3) * 512 + (s & 63) * 8);
                        *(u32x4*)(KV + ((size_t)sl * 8 + b * 4 + g) * 8192 * 64 + off) = pack8(acc[ai][bj][m][0] * rs, acc[ai][bj][m][1] * rs); }
                } else if (u.pn < 12) {
#pragma unroll
                    for (int bj = 0; bj < 2; ++bj) *(u32x4*)(XQ + (size_t)row * 512 + (u.pn - 10) * BM + bj * HALF + wc * 32 + 8 * fq) = pack8(acc[ai][bj][m][0] * rs, acc[ai][bj][m][1] * rs);
                } else {
                    const int ct = wc * 32 + 8 * fq;
                    if (ct < 48) { f32x4 g0, g1;
#pragma unroll
                        for (int e = 0; e < 4; ++e) { g0[e] = sigm_f(acc[ai][0][m][0][e] * rs); g1[e] = sigm_f(acc[ai][0][m][1][e] * rs); }
                        *(f32x4*)(GATES + (size_t)row * 48 + ct) = g0; *(f32x4*)(GATES + (size_t)row * 48 + ct + 4) = g1; }
                } }
    }
};
struct EpiRes {
    static constexpr bool PERM = true, AFTER_DRAIN = false;
    const float* base; float* out; bf16_t* xn; float* stats;
    __device__ __forceinline__ void operator()(const f32x4 (&acc)[2][2][4][2], const Unit& u, int wr, int wc, int fr, int fq) const {
#pragma unroll
        for (int ai = 0; ai < 2; ++ai)
#pragma unroll
            for (int m = 0; m < 4; ++m) { const int row = u.pm * BM + ai * HALF + wr * 64 + m * 16 + fr; float ss = 0.f;
#pragma unroll
                for (int bj = 0; bj < 2; ++bj) { const size_t off = (size_t)row * 1024 + u.pn * BM + bj * HALF + wc * 32 + 8 * fq;
                    const f32x4 v0 = *(const f32x4*)(base + off) + acc[ai][bj][m][0], v1 = *(const f32x4*)(base + off + 4) + acc[ai][bj][m][1];
                    *(f32x4*)(out + off) = v0; *(f32x4*)(out + off + 4) = v1; *(u32x4*)(xn + off) = pack8(v0, v1);
                    ss += (v0[0] * v0[0] + v0[1] * v0[1]) + (v0[2] * v0[2] + v0[3] * v0[3]) + (v1[0] * v1[0] + v1[1] * v1[1]) + (v1[2] * v1[2] + v1[3] * v1[3]); }
                ss += __shfl_xor(ss, 16); ss += __shfl_xor(ss, 32);
                if (fq == 0) stats[(size_t)row * 16 + u.pn * 4 + wc] = ss; }
    }
};

template <class Epi, class Sched, bool ALIGN_EPI = false, bool SP2 = false>
__device__ __forceinline__ void gemm_phase(PG8_LAS unsigned char* lds, const Gemm g, const Sched& S, const Epi& E) {
    const int tid = threadIdx.x, wid = __builtin_amdgcn_readfirstlane(tid >> 6), lane = tid & 63, wr = wid >> 2, wc = wid & 3, fr = lane & 15, fq = lane >> 4;
    const int K = g.K, nt = K / BK;
    unsigned voffA[2], voffB[2];
#pragma unroll
    for (int i = 0; i < 2; ++i) { int R, C; stage_rc(tid * 16 + i * 8192, R, C); const int Rb = Epi::PERM ? ((R & ~31) + perm32(R & 31)) : R;
        voffA[i] = (unsigned)(R * g.lda + C) * 2u; voffB[i] = (unsigned)(Rb * K + C) * 2u; }
    const size_t kstep = (size_t)(BK * 2);
    const size_t hstepB = (size_t)HALF * K * 2, hstepA = (size_t)HALF * g.lda * 2;
    const size_t tstepB = 2 * hstepB, tstepA = 2 * hstepA;
    const unsigned ldsw = (unsigned)wid * 1024u;
    const int aoff = lds_byte(wr * 64 + fr, fq * 8), boff = lds_byte(wc * 32 + fr, fq * 8);
#define PG8_SA(b, h) (((b) * 2 + (h)) * HTB)
#define PG8_SB(b, h) ((4 + (b) * 2 + (h)) * HTB)
#define PG8_STAGE(bufoff, gbase, voff) do { _Pragma("unroll") for (int _i = 0; _i < 2; ++_i) \
        __builtin_amdgcn_global_load_lds((const unsigned*)((const char*)(gbase) + (voff)[_i]), (PG8_LAS unsigned*)(lds + (bufoff) + ldsw + _i * 8192), 16, 0, 0); } while (0)
#define PG8_LDA(dst, b, h) do { _Pragma("unroll") for (int m = 0; m < 4; ++m) _Pragma("unroll") for (int k = 0; k < 2; ++k) dst[m][k] = *(const PG8_LAS bf16x8*)(lds + PG8_SA(b, h) + aoff + m * 2048 + k * 1024); } while (0)
#define PG8_LDB(dst, b, h) do { _Pragma("unroll") for (int n = 0; n < 2; ++n) _Pragma("unroll") for (int k = 0; k < 2; ++k) dst[n][k] = *(const PG8_LAS bf16x8*)(lds + PG8_SB(b, h) + boff + n * 2048 + k * 1024); } while (0)
#define PG8_MMA(ai, bj, At, Bt) do { __builtin_amdgcn_s_setprio(1); _Pragma("unroll") for (int m = 0; m < 4; ++m) _Pragma("unroll") for (int n = 0; n < 2; ++n) _Pragma("unroll") for (int k = 0; k < 2; ++k) \
        acc[ai][bj][m][n] = __builtin_amdgcn_mfma_f32_16x16x32_bf16(Bt[n][k], At[m][k], acc[ai][bj][m][n], 0, 0, 0); __builtin_amdgcn_s_setprio(0); } while (0)
#define PG8_WAIT_V(n) asm volatile("s_waitcnt vmcnt(" #n ")" ::: "memory")
#define PG8_WAIT_L(n) asm volatile("s_waitcnt lgkmcnt(" #n ")" ::: "memory")
#define PG8_BAR __builtin_amdgcn_s_barrier()
#define PG8_SCHED __builtin_amdgcn_sched_barrier(0)
    Unit cur, nxt; int ui = 0;
    if (!S.next(0, cur)) return;
    f32x4 acc[2][2][4][2];
#pragma unroll
    for (int a = 0; a < 2; ++a)
#pragma unroll
        for (int b = 0; b < 2; ++b)
#pragma unroll
            for (int m = 0; m < 4; ++m)
#pragma unroll
                for (int n = 0; n < 2; ++n) acc[a][b][m][n] = (f32x4){0.f, 0.f, 0.f, 0.f};
    bf16x8 At[4][2], B0[2][2], B1[2][2];
    const char* cA = (const char*)g.A + (size_t)cur.pm * tstepA; const char* cB = (const char*)g.Bt + (size_t)cur.pn * tstepB;
    S.a_ready(cur);
    if constexpr (SP2) {
        PG8_STAGE(PG8_SB(0, 0), cB, voffB); PG8_STAGE(PG8_SB(0, 1), cB + hstepB, voffB); PG8_STAGE(PG8_SA(0, 0), cA, voffA); PG8_STAGE(PG8_SA(0, 1), cA + hstepA, voffA);
        if (wr == 1) PG8_BAR;
        PG8_WAIT_V(2); PG8_BAR;
        PG8_STAGE(PG8_SB(1, 0), cB + kstep, voffB); PG8_STAGE(PG8_SA(1, 0), cA + kstep, voffA); PG8_STAGE(PG8_SB(1, 1), cB + hstepB + kstep, voffB);
        PG8_WAIT_V(6); PG8_BAR;
    } else {
        PG8_STAGE(PG8_SB(0, 0), cB, voffB); PG8_STAGE(PG8_SA(0, 0), cA, voffA); PG8_STAGE(PG8_SB(0, 1), cB + hstepB, voffB); PG8_STAGE(PG8_SA(0, 1), cA + hstepA, voffA);
        if (wr == 1) PG8_BAR;
        PG8_WAIT_V(4); PG8_BAR;
        PG8_STAGE(PG8_SB(1, 0), cB + kstep, voffB); PG8_STAGE(PG8_SA(1, 0), cA + kstep, voffA); PG8_STAGE(PG8_SB(1, 1), cB + hstepB + kstep, voffB);
        PG8_WAIT_V(6); PG8_BAR;
    }
    for (;;) {
        const bool has_next = S.next(ui + 1, nxt);
        const char* nA = has_next ? (const char*)g.A + (size_t)nxt.pm * tstepA : cA; const char* nB = has_next ? (const char*)g.Bt + (size_t)nxt.pn * tstepB : cB;
        for (int t = 0; t < nt; t += 2) {
            const bool last = (t == nt - 2);
            const char* a1 = cA + (size_t)(t + 1) * kstep;
            const char* a2 = last ? nA : cA + (size_t)(t + 2) * kstep; const char* b2 = last ? nB : cB + (size_t)(t + 2) * kstep;
            const char* a3 = a2 + kstep; const char* b3 = b2 + kstep;
            if (last && has_next) S.a_ready(nxt);
            if constexpr (SP2) {
            PG8_LDB(B0, 0, 0); PG8_LDB(B1, 0, 1); PG8_SCHED; PG8_LDA(At, 0, 0); PG8_STAGE(PG8_SA(1, 1), a1 + hstepA, voffA);
            PG8_WAIT_V(8); PG8_WAIT_L(0); PG8_BAR; PG8_MMA(0, 0, At, B0); PG8_MMA(0, 1, At, B1); PG8_BAR; PG8_SCHED;
            PG8_LDA(At, 0, 1); PG8_STAGE(PG8_SB(0, 0), b2, voffB); PG8_STAGE(PG8_SB(0, 1), b2 + hstepB, voffB); PG8_STAGE(PG8_SA(0, 0), a2, voffA);
            PG8_WAIT_V(8); PG8_WAIT_L(0); PG8_BAR; PG8_MMA(1, 0, At, B0); PG8_MMA(1, 1, At, B1); PG8_BAR; PG8_SCHED;
            PG8_LDB(B0, 1, 0); PG8_LDB(B1, 1, 1); PG8_SCHED; PG8_LDA(At, 1, 0); PG8_STAGE(PG8_SA(0, 1), a2 + hstepA, voffA);
            PG8_WAIT_V(8); PG8_WAIT_L(0); PG8_BAR; PG8_MMA(0, 0, At, B0); PG8_MMA(0, 1, At, B1); PG8_BAR; PG8_SCHED;
            PG8_LDA(At, 1, 1); PG8_STAGE(PG8_SB(1, 0), b3, voffB); PG8_STAGE(PG8_SB(1, 1), b3 + hstepB, voffB); PG8_STAGE(PG8_SA(1, 0), a3, voffA);
            PG8_WAIT_V(8); PG8_WAIT_L(0); PG8_BAR; PG8_MMA(1, 0, At, B0); PG8_MMA(1, 1, At, B1); PG8_BAR; PG8_SCHED;
            } else {
            PG8_LDB(B0, 0, 0); PG8_SCHED; PG8_LDA(At, 0, 0); PG8_STAGE(PG8_SA(1, 1), a1 + hstepA, voffA);
            PG8_WAIT_L(8); PG8_BAR; PG8_WAIT_L(0); PG8_MMA(0, 0, At, B0); PG8_BAR; PG8_SCHED;
            PG8_LDB(B1, 0, 1); PG8_STAGE(PG8_SB(0, 0), b2, voffB);
            PG8_BAR; PG8_WAIT_L(0); PG8_MMA(0, 1, At, B1); PG8_BAR;
            PG8_LDA(At, 0, 1); PG8_STAGE(PG8_SA(0, 0), a2, voffA);
            PG8_BAR; PG8_WAIT_L(0); PG8_MMA(1, 0, At, B0); PG8_BAR; PG8_SCHED;
            PG8_STAGE(PG8_SB(0, 1), b2 + hstepB, voffB);
            PG8_WAIT_V(6); PG8_BAR; PG8_MMA(1, 1, At, B1); PG8_BAR;
            PG8_LDB(B0, 1, 0); PG8_SCHED; PG8_LDA(At, 1, 0); PG8_STAGE(PG8_SA(0, 1), a2 + hstepA, voffA);
            PG8_WAIT_L(8); PG8_BAR; PG8_WAIT_L(0); PG8_MMA(0, 0, At, B0); PG8_BAR; PG8_SCHED;
            PG8_LDB(B1, 1, 1); PG8_STAGE(PG8_SB(1, 0), b3, voffB);
            PG8_BAR; PG8_WAIT_L(0); PG8_MMA(0, 1, At, B1); PG8_BAR;
            PG8_LDA(At, 1, 1); PG8_STAGE(PG8_SA(1, 0), a3, voffA);
            PG8_BAR; PG8_WAIT_L(0); PG8_MMA(1, 0, At, B0); PG8_BAR; PG8_SCHED;
            PG8_STAGE(PG8_SB(1, 1), b3 + hstepB, voffB);
            PG8_WAIT_V(6); PG8_BAR; PG8_MMA(1, 1, At, B1); PG8_BAR;
            }
        }
        if constexpr (ALIGN_EPI) { if (wr == 0) PG8_BAR; }
        if constexpr (!Epi::AFTER_DRAIN) { E(acc, cur, wr, wc, fr, fq); S.done(cur); }
        if (!has_next) break;
#pragma unroll
        for (int a = 0; a < 2; ++a)
#pragma unroll
            for (int b = 0; b < 2; ++b)
#pragma unroll
                for (int m = 0; m < 4; ++m)
#pragma unroll
                    for (int n = 0; n < 2; ++n) acc[a][b][m][n] = (f32x4){0.f, 0.f, 0.f, 0.f};
        cur = nxt; cA = nA; cB = nB; ++ui;
        if constexpr (ALIGN_EPI) { if (wr == 1) PG8_BAR; }
    }
    PG8_WAIT_V(0);
    if constexpr (!ALIGN_EPI) { if (wr == 0) PG8_BAR; }
    PG8_BAR;
    if constexpr (Epi::AFTER_DRAIN) { E.fused(acc, cur, wr, wc, fr, fq, lds, wid, lane); S.done(cur); }
#undef PG8_SA
#undef PG8_SB
#undef PG8_STAGE
#undef PG8_LDA
#undef PG8_LDB
#undef PG8_MMA
#undef PG8_WAIT_V
#undef PG8_WAIT_L
#undef PG8_BAR
#undef PG8_SCHED
}
}
#define GAS __attribute__((address_space(1)))
#define LAS __attribute__((address_space(3)))
typedef unsigned short bf16;
typedef unsigned v4u __attribute__((ext_vector_type(4)));
typedef float f32x4 __attribute__((ext_vector_type(4)));
typedef short bf16x8 __attribute__((ext_vector_type(8)));
typedef GAS unsigned gu32;
typedef GAS unsigned long long gu64;
#define RLX_AGENT __ATOMIC_RELAXED, __HIP_MEMORY_SCOPE_AGENT
#define LDS_WAIT() asm volatile("s_waitcnt lgkmcnt(0)" ::: "memory")
#define VM_WAIT() asm volatile("s_waitcnt vmcnt(0)" ::: "memory")
__device__ __forceinline__ unsigned long long rt() { return __builtin_amdgcn_s_memrealtime(); }
__device__ __forceinline__ unsigned f2bf(float f) { unsigned u = __builtin_bit_cast(unsigned, f); return (u + 0x7fffu + ((u >> 16) & 1u)) >> 16; }
__device__ __forceinline__ unsigned pk2(float lo, float hi) { return f2bf(lo) | (f2bf(hi) << 16); }

#define XB_TMO      128
#define XB_XCNT(j)  (256  + 64 * (j))
#define XB_XSUB(j)  (1280 + 64 * (j))
#define XB_XGEN(j)  (2304 + 64 * (j))
#define XB_TOP      3328
#define XB_TOPGEN   3392
#define XCD_BAR_WORDS 3456
#define XB_SPIN_CAP (1u << 18)

__device__ __forceinline__ unsigned xb_ld(unsigned* p)              { return __hip_atomic_load(p, __ATOMIC_RELAXED, __HIP_MEMORY_SCOPE_AGENT); }
__device__ __forceinline__ unsigned xb_add(unsigned* p, unsigned v) { return __hip_atomic_fetch_add(p, v, __ATOMIC_RELAXED, __HIP_MEMORY_SCOPE_AGENT); }
__device__ __forceinline__ unsigned xb_xcc_id() { return (unsigned)__builtin_amdgcn_s_getreg((3 << 11) | 20) & 0xFu; }
#define XB_SPIN(cond, bar) do { unsigned _sp = 0; while (cond) { __builtin_amdgcn_s_sleep(1); \
    if ((++_sp & 255u) == 0u) { if (xb_ld(&(bar)[XB_TMO])) break; if (_sp > XB_SPIN_CAP) { atomicAdd(&(bar)[XB_TMO], 1u); break; } } } } while (0)

struct XcdBarrier {
    unsigned* bar; unsigned x;
    volatile LAS unsigned* st;
};

__device__ __forceinline__ XcdBarrier xcd_barrier_post(unsigned* bar, volatile LAS unsigned* st) {
    XcdBarrier b; b.bar = bar; b.x = xb_xcc_id(); b.st = st;
    if (threadIdx.x == 0) (void)xb_add(&bar[XB_XCNT(b.x)], 1u);
    return b;
}
__device__ __forceinline__ void xcd_barrier_complete(unsigned* bar, unsigned x, unsigned& nloc, unsigned& nx) {
    const unsigned G = gridDim.x * gridDim.y * gridDim.z;
    unsigned sum, cnt, mine, sp = 0u;
    for (;;) {
        sum = 0u; cnt = 0u; mine = 0u;
#pragma unroll
        for (unsigned j = 0; j < 16; ++j) { const unsigned c = xb_ld(&bar[XB_XCNT(j)]); sum += c; cnt += (c > 0u) ? 1u : 0u; mine = (j == x) ? c : mine; }
        if (sum == G) break;
        __builtin_amdgcn_s_sleep(1);
        if ((++sp & 255u) == 0u) { if (xb_ld(&bar[XB_TMO])) break; if (sp > XB_SPIN_CAP) { atomicAdd(&bar[XB_TMO], 1u); break; } }
    }
    nloc = mine > 0u ? mine : 1u; nx = cnt > 0u ? cnt : 1u;
}

__device__ __forceinline__ void xcd_barrier(const XcdBarrier& b) {
    asm volatile("s_waitcnt vmcnt(0)" ::: "memory");
    __syncthreads();
    if (threadIdx.x == 0) {
        unsigned* bar = b.bar;
        __builtin_amdgcn_s_waitcnt(0);
        unsigned nloc = b.st[0], nx = b.st[1];
        if (nloc == 0u) { xcd_barrier_complete(bar, b.x, nloc, nx); b.st[0] = nloc; b.st[1] = nx; }
        const unsigned old = xb_add(&bar[XB_XSUB(b.x)], 1u);
        const unsigned gen = old / nloc;
        if (old + 1u == (gen + 1u) * nloc) {
            __builtin_amdgcn_fence(__ATOMIC_RELEASE, "agent");
            asm volatile("s_waitcnt vmcnt(0)" ::: "memory");
            const unsigned og = xb_add(&bar[XB_TOP], 1u);
            const unsigned tg = og / nx;
            if (og + 1u == (tg + 1u) * nx) xb_add(&bar[XB_TOPGEN], 1u);
            else XB_SPIN(xb_ld(&bar[XB_TOPGEN]) == tg, bar);
            __builtin_amdgcn_fence(__ATOMIC_ACQUIRE, "agent");
            xb_add(&bar[XB_XGEN(b.x)], 1u);
            asm volatile("s_waitcnt vmcnt(0)" ::: "memory");
        } else {
            XB_SPIN(xb_ld(&bar[XB_XGEN(b.x)]) == gen, bar);
            __builtin_amdgcn_fence(__ATOMIC_ACQUIRE, "agent");
            asm volatile("s_waitcnt vmcnt(0)" ::: "memory");
        }
    }
    __syncthreads();
}

constexpr int NWAVES = 8;
constexpr int BATCH = 2, SEQ = 8192, DM = 1024, MTOK = BATCH * SEQ, NMEM = 256, FFH = 2816, MIXW = 1536, XW = 512;
constexpr int CONV_N = 3584, NSA_N = 3328, NSA_SRC = 3120, NCMP = 511;
constexpr size_t MiB = 1u << 20;
constexpr size_t WS_CTL = 0, CTL_ZERO_BYTES = 1 * MiB;
constexpr size_t WS_STATS = 1 * MiB;
constexpr size_t WS_TAB = 2 * MiB;
constexpr size_t WS_MEMN = 3 * MiB;
constexpr size_t WS_KVM = 5 * MiB;
constexpr size_t WS_CMP = 9 * MiB;
constexpr size_t WS_GATES = 11 * MiB;
constexpr size_t WS_WCONV = 14 * MiB;
constexpr size_t WS_WNSA = 21 * MiB;
constexpr size_t WS_WOUT = 28 * MiB;
constexpr size_t WS_WFFI = 34 * MiB;
constexpr size_t WS_WFFO = 56 * MiB;
constexpr size_t WS_WMKV = 67 * MiB;
constexpr size_t WS_WC1 = 71 * MiB;
constexpr size_t WS_WC2 = 72 * MiB;
constexpr size_t WS_XN = 73 * MiB;
constexpr size_t WS_MIX = 105 * MiB;
constexpr size_t WS_UNION = 153 * MiB;
constexpr size_t WS_UB = WS_UNION, WS_V = WS_UNION + 32 * MiB, WS_XQ0 = WS_UNION + 64 * MiB;
constexpr size_t WS_HID = WS_UNION;
constexpr size_t WS_Q = WS_UNION, WS_KV = WS_UNION + 32 * MiB, WS_XQ1 = WS_UNION + 82 * MiB;
constexpr size_t WS_END = 253 * MiB;
static_assert(WS_XQ1 + 16 * MiB <= WS_END && WS_HID + 88 * MiB <= WS_END, "ws map");
constexpr int CW_BAR = 4096;

constexpr int RING_OFF = 0, RING_BYTES = 131072;
constexpr int LDSCTL_OFF = RING_BYTES, MISC_OFF = LDSCTL_OFF + 320;
constexpr int LDS_BYTES = 147456;

struct Frame {
    LAS unsigned char* lds;
    volatile LAS unsigned* MISC;
    gu32* ctl;
    int tid, lane, wave, vcu, G;
};
__device__ __forceinline__ float wave_sum(float v) {
#pragma unroll
    for (int o = 1; o < 64; o <<= 1) v += __shfl_xor(v, o);
    return v;
}
struct Args { const float* in[20]; float* out; unsigned char* ws; int ph_lo, ph_hi, li, pad; };


namespace att {
typedef float f32x16 __attribute__((ext_vector_type(16)));
typedef short s16x4 __attribute__((ext_vector_type(4)));
typedef short v4i16_t __attribute__((ext_vector_type(4)));
typedef __attribute__((address_space(3))) const unsigned char* lcp;
constexpr float LOG2E = 1.4426950408889634f;
constexpr float NEG_BIG = -1.0e30f;
__device__ __forceinline__ unsigned cvtpk(float lo, float hi) { typedef float f2 __attribute__((ext_vector_type(2))); typedef __bf16 b2 __attribute__((ext_vector_type(2))); f2 v = {lo, hi}; b2 b = __builtin_convertvector(v, b2); return __builtin_bit_cast(unsigned, b); }
__device__ __forceinline__ float xhalf_max(float m) { auto rr = __builtin_amdgcn_permlane32_swap(__float_as_uint(m), __float_as_uint(m), false, false); return fmaxf(__uint_as_float(rr[0]), __uint_as_float(rr[1])); }
__device__ __forceinline__ float xhalf_sum(float m) { auto rr = __builtin_amdgcn_permlane32_swap(__float_as_uint(m), __float_as_uint(m), false, false); return __uint_as_float(rr[0]) + __uint_as_float(rr[1]); }
__device__ __forceinline__ s16x4 vtr(lcp p) { return __builtin_bit_cast(s16x4, __builtin_amdgcn_ds_read_tr16_b64_v4i16((__attribute__((address_space(3))) v4i16_t*)p)); }

template <int NB> __device__ __forceinline__ void dma_tile(const void* gsrc, LAS unsigned char* slot, int wave, int lane) {
#pragma unroll
    for (int i = 0; i < NB / 8192; ++i)
        __builtin_amdgcn_global_load_lds((const unsigned*)((const unsigned char*)gsrc + (i * 8 + wave) * 1024 + lane * 16), (LAS unsigned*)(slot + (i * 8 + wave) * 1024), 16, 0, 0);
}
template <int D> __device__ __forceinline__ void qk_tile(f32x16& p0, f32x16& p1, lcp Kslot, const bf16x8 (&q)[D / 16], int r, int hh) {
    lcp kb = Kslot + hh * 1024 + r * 16;
    p0 = (f32x16){0.f}; p1 = (f32x16){0.f};
#pragma unroll
    for (int ks = 0; ks < D / 16; ++ks) {
        const bf16x8 a0 = *(const LAS bf16x8*)(kb + ks * 2048), a1 = *(const LAS bf16x8*)(kb + ks * 2048 + 512);
        p0 = __builtin_amdgcn_mfma_f32_32x32x16_bf16(a0, q[ks], p0, 0, 0, 0);
        p1 = __builtin_amdgcn_mfma_f32_32x32x16_bf16(a1, q[ks], p1, 0, 0, 0);
    }
}
template <int D> __device__ __forceinline__ void pv_tile(f32x16 (&o)[D / 32], lcp Vslot, const f32x16& p0, const f32x16& p1, int lane) {
    const int hh = lane >> 5;
    lcp vb = Vslot + ((lane >> 4) & 1) * 32 + (lane & 3) * 8 + (4 * hh + ((lane & 15) >> 2)) * 64;
    v4u pw[4];
    pw[0] = (v4u){cvtpk(p0[0], p0[1]), cvtpk(p0[2], p0[3]), cvtpk(p0[4], p0[5]), cvtpk(p0[6], p0[7])};
    pw[1] = (v4u){cvtpk(p0[8], p0[9]), cvtpk(p0[10], p0[11]), cvtpk(p0[12], p0[13]), cvtpk(p0[14], p0[15])};
    pw[2] = (v4u){cvtpk(p1[0], p1[1]), cvtpk(p1[2], p1[3]), cvtpk(p1[4], p1[5]), cvtpk(p1[6], p1[7])};
    pw[3] = (v4u){cvtpk(p1[8], p1[9]), cvtpk(p1[10], p1[11]), cvtpk(p1[12], p1[13]), cvtpk(p1[14], p1[15])};
#pragma unroll
    for (int d0 = 0; d0 < D / 32; ++d0)
#pragma unroll
        for (int s = 0; s < 4; ++s) {
            const s16x4 lo = vtr(vb + d0 * 4096 + s * 1024), hi = vtr(vb + d0 * 4096 + s * 1024 + 512);
            const bf16x8 vf = (bf16x8){lo[0], lo[1], lo[2], lo[3], hi[0], hi[1], hi[2], hi[3]};
            o[d0] = __builtin_amdgcn_mfma_f32_32x32x16_bf16(vf, __builtin_bit_cast(bf16x8, pw[s]), o[d0], 0, 0, 0);
        }
}
template <int ND> __device__ __forceinline__ void softmax_step(f32x16& p0, f32x16& p1, float& m, float& l, f32x16 (&o)[ND]) {
    float mx = fmaxf(p0[0], p1[0]);
#pragma unroll
    for (int i = 1; i < 16; ++i) mx = fmaxf(mx, fmaxf(p0[i], p1[i]));
    mx = xhalf_max(mx);
    const float mn = fmaxf(m, mx);
    const float alpha = __builtin_amdgcn_exp2f(m - mn);
    float s = 0.f;
#pragma unroll
    for (int i = 0; i < 16; ++i) { p0[i] = p0[i] > -1.0e29f ? __builtin_amdgcn_exp2f(p0[i] - mn) : 0.f; p1[i] = p1[i] > -1.0e29f ? __builtin_amdgcn_exp2f(p1[i] - mn) : 0.f; s += p0[i] + p1[i]; }
    l = l * alpha + s; m = mn;
#pragma unroll
    for (int d = 0; d < ND; ++d) o[d] = o[d] * alpha;
}
}

constexpr size_t WS_MKI = 5 * MiB;
constexpr size_t WS_MVI = 6 * MiB;
constexpr size_t WS_KCI = 9 * MiB;
constexpr size_t WS_VCI = 10 * MiB;
constexpr size_t TAB_BIAS2 = 0;
constexpr size_t TAB_POSB = 16384;
__device__ const unsigned char T5TAB[128] = {0, 1, 2, 3, 4, 5, 6, 7, 8, 9, 10, 11, 12, 13, 14, 15, 16, 16, 16, 17, 17, 18, 18, 18, 19, 19, 19, 20, 20, 20, 20, 21, 21, 21, 21, 22, 22, 22, 22, 22, 23, 23, 23, 23, 23, 23, 24, 24, 24, 24, 24, 24, 25, 25, 25, 25, 25, 25, 25, 26, 26, 26, 26, 26, 26, 26, 26, 27, 27, 27, 27, 27, 27, 27, 27, 27, 27, 28, 28, 28, 28, 28, 28, 28, 28, 28, 28, 29, 29, 29, 29, 29, 29, 29, 29, 29, 29, 29, 29, 30, 30, 30, 30, 30, 30, 30, 30, 30, 30, 30, 30, 30, 30, 31, 31, 31, 31, 31, 31, 31, 31, 31, 31, 31, 31, 31, 31, 31};

__device__ __forceinline__ void p0_tables(Frame& F, const Args& a) {
    const int gw = F.vcu * NWAVES + F.wave;
    float* tab = (float*)(a.ws + WS_TAB);
    if (gw < 32) {
        const int h = gw >> 1, d = (gw & 1) * 64 + F.lane;
        tab[TAB_BIAS2 / 4 + h * 128 + d] = a.in[15][(int)T5TAB[d] * 16 + h] * att::LOG2E;
    } else if (gw < 64) {
        const int it = gw - 32, kq = it >> 2, kv = (it >> 1) & 1, n = (it & 1) * 64 + F.lane;
        const float* pos = a.in[kv ? 12 : 9]; const float* w1 = a.in[kv ? 13 : 10];
        float s = 0.f;
        for (int k = kq * 256; k < kq * 256 + 256; ++k) s += pos[k] * w1[(size_t)k * 128 + n];
        tab[TAB_POSB / 4 + (kq * 2 + kv) * 128 + n] = s;
    }
}

__device__ __forceinline__ void conv_phase(Frame& F, const Args& a) {
    const bf16* UB = (const bf16*)(a.ws + WS_UB); const bf16* V = (const bf16*)(a.ws + WS_V); bf16* MIX = (bf16*)(a.ws + WS_MIX); const float* cw = a.in[7];
    for (int blk = F.vcu; blk < MTOK / 64; blk += F.G) {
        for (int idx = F.tid; idx < 64 * 128; idx += NWAVES * 64) {
            const int t = blk * 64 + (idx >> 7), c = (idx & 127) * 8, tl = t & (SEQ - 1);
            const bf16x8 ub = *(const bf16x8*)(UB + (size_t)t * DM + c), v2 = *(const bf16x8*)(V + (size_t)t * DM + c);
            bf16x8 v1 = (bf16x8){0, 0, 0, 0, 0, 0, 0, 0}, v0 = v1;
            if (tl >= 1) v1 = *(const bf16x8*)(V + (size_t)(t - 1) * DM + c);
            if (tl >= 2) v0 = *(const bf16x8*)(V + (size_t)(t - 2) * DM + c);
            const f32x4 wa0 = *(const f32x4*)(cw + c), wa1 = *(const f32x4*)(cw + c + 4), wb0 = *(const f32x4*)(cw + DM + c), wb1 = *(const f32x4*)(cw + DM + c + 4), wc0 = *(const f32x4*)(cw + 2 * DM + c), wc1 = *(const f32x4*)(cw + 2 * DM + c + 4);
            float o[8];
#pragma unroll
            for (int e = 0; e < 8; ++e) { const float w0 = e < 4 ? wa0[e & 3] : wa1[e & 3], w1 = e < 4 ? wb0[e & 3] : wb1[e & 3], w2 = e < 4 ? wc0[e & 3] : wc1[e & 3];
                const float f0 = __uint_as_float((unsigned)(unsigned short)v0[e] << 16), f1 = __uint_as_float((unsigned)(unsigned short)v1[e] << 16), f2 = __uint_as_float((unsigned)(unsigned short)v2[e] << 16), fb = __uint_as_float((unsigned)(unsigned short)ub[e] << 16);
                o[e] = fb * (w0 * f0 + w1 * f1 + w2 * f2); }
            v4u w; w.x = att::cvtpk(o[0], o[1]); w.y = att::cvtpk(o[2], o[3]); w.z = att::cvtpk(o[4], o[5]); w.w = att::cvtpk(o[6], o[7]);
            *(v4u*)(MIX + (size_t)t * MIXW + c) = w;
        }
    }
}

__device__ __forceinline__ void memattn_phase(Frame& F, const Args& a, int layer, const bf16* XQ) {
    using namespace att;
    bf16* MIX = (bf16*)(a.ws + WS_MIX);
    const int lane = F.lane, r = lane & 31, hh = lane >> 5;
    LAS unsigned char* Ks = F.lds + RING_OFF; LAS unsigned char* Vs = F.lds + RING_OFF + 32768;
    for (int u = F.vcu; u < 256; u += F.G) {
        const int b = u >> 7, head = (u >> 5) & 3, qb = u & 31;
        const unsigned char* Kimg = a.ws + WS_MKI + (size_t)((layer * 2 + b) * 4 + head) * 65536; const unsigned char* Vimg = a.ws + WS_MVI + (size_t)((layer * 2 + b) * 4 + head) * 65536;
        const size_t row = (size_t)b * SEQ + qb * 256 + F.wave * 32 + r;
        bf16x8 q[8];
#pragma unroll
        for (int ks = 0; ks < 8; ++ks) q[ks] = *(const bf16x8*)(XQ + row * XW + head * 128 + 16 * ks + 8 * hh);
        f32x16 o[4]; o[0] = (f32x16){0.f}; o[1] = o[0]; o[2] = o[0]; o[3] = o[0];
        float m = NEG_BIG, l = 0.f;
        dma_tile<16384>(Kimg, Ks, F.wave, lane); dma_tile<16384>(Vimg, Vs, F.wave, lane);
#pragma unroll 1
        for (int t = 0; t < 4; ++t) {
            asm volatile("s_waitcnt vmcnt(0)" ::: "memory"); __syncthreads();
            if (t + 1 < 4) { dma_tile<16384>(Kimg + (t + 1) * 16384, Ks + ((t + 1) & 1) * 16384, F.wave, lane); dma_tile<16384>(Vimg + (t + 1) * 16384, Vs + ((t + 1) & 1) * 16384, F.wave, lane); }
            f32x16 p0, p1;
            qk_tile<128>(p0, p1, (lcp)(Ks + (t & 1) * 16384), q, r, hh);
            const float sc = 0.08838834764831845f * LOG2E;
#pragma unroll
            for (int i = 0; i < 16; ++i) { p0[i] *= sc; p1[i] *= sc; }
            softmax_step<4>(p0, p1, m, l, o);
            pv_tile<128>(o, (lcp)(Vs + (t & 1) * 16384), p0, p1, lane);
        }
        l = xhalf_sum(l); const float inv = 1.f / l;
        bf16* orow = MIX + row * MIXW + 1024 + head * 128 + 4 * hh;
#pragma unroll
        for (int d0 = 0; d0 < 4; ++d0)
#pragma unroll
            for (int i4 = 0; i4 < 4; ++i4) { typedef unsigned u32x2 __attribute__((ext_vector_type(2)));
                u32x2 w; w.x = cvtpk(o[d0][4 * i4] * inv, o[d0][4 * i4 + 1] * inv); w.y = cvtpk(o[d0][4 * i4 + 2] * inv, o[d0][4 * i4 + 3] * inv);
                *(u32x2*)(orow + 32 * d0 + 8 * i4) = w; }
        __syncthreads();
    }
}

__device__ __forceinline__ void cmpmlp_phase(Frame& F, const Args& a) {
    using namespace att;
    const int lane = F.lane, r = lane & 31, hh = lane >> 5, rh = F.wave >> 2, ct = F.wave & 3;
    const float* tab = (const float*)(a.ws + WS_TAB);
    LAS unsigned short* HM = (LAS unsigned short*)(F.lds + RING_OFF);
    for (int u = F.vcu; u < 128; u += F.G) {
        const int kv = u >> 6, bg = (u >> 3) & 7, rb = u & 7;
        const bf16* raw = (const bf16*)(a.ws + WS_KV) + (size_t)(kv * 8 + bg) * 8192 * 64;
        const bf16* W1T = (const bf16*)(a.ws + WS_WC1) + (size_t)kv * 128 * 2048;
        const bf16* ap = raw + (size_t)(rb * 64 + rh * 32 + r) * 1024 + 8 * hh;
        const bf16* bp = W1T + (size_t)(ct * 32 + r) * 2048 + 8 * hh;
        f32x16 acc = (f32x16){0.f};
#pragma unroll 8
        for (int ks = 0; ks < 128; ++ks) acc = __builtin_amdgcn_mfma_f32_32x32x16_bf16(*(const bf16x8*)(ap + 16 * ks), *(const bf16x8*)(bp + 16 * ks), acc, 0, 0, 0);
        const int n = ct * 32 + r; float pb = 0.f;
#pragma unroll
        for (int kq = 0; kq < 8; ++kq) pb += tab[TAB_POSB / 4 + (kq * 2 + kv) * 128 + n];
#pragma unroll
        for (int i = 0; i < 16; ++i) { const float x = acc[i] + pb; const float hm = x * __builtin_amdgcn_rcpf(1.f + __builtin_amdgcn_exp2f(-LOG2E * x));
            const int c = rh * 32 + (i & 3) + 8 * (i >> 2) + 4 * hh; HM[c * 136 + n] = (unsigned short)(cvtpk(hm, 0.f) & 0xffffu); }
        __syncthreads();
        if (F.wave < 4) {
            const int rh2 = F.wave >> 1, dt = F.wave & 1;
            const bf16* W2T = (const bf16*)(a.ws + WS_WC2) + (size_t)kv * 64 * 128;
            f32x16 o = (f32x16){0.f};
#pragma unroll
            for (int ks = 0; ks < 8; ++ks) { const bf16x8 af = *(const LAS bf16x8*)(HM + (rh2 * 32 + r) * 136 + 16 * ks + 8 * hh); const bf16x8 bfr = *(const bf16x8*)(W2T + (size_t)(dt * 32 + r) * 128 + 16 * ks + 8 * hh);
                o = __builtin_amdgcn_mfma_f32_32x32x16_bf16(af, bfr, o, 0, 0, 0); }
            const int d = dt * 32 + r;
            bf16* img = (bf16*)(a.ws + (kv ? WS_VCI : WS_KCI)) + (size_t)bg * 512 * 64;
#pragma unroll
            for (int i = 0; i < 16; ++i) { const int c = rb * 64 + rh2 * 32 + (i & 3) + 8 * (i >> 2) + 4 * hh; const float v = c < NCMP ? o[i] : 0.f;
                const size_t off = kv ? ((size_t)(c >> 6) * 4096 + (d >> 5) * 2048 + (c & 63) * 32 + (d & 31)) : ((size_t)(c >> 6) * 4096 + (d >> 3) * 512 + (c & 63) * 8 + (d & 7));
                img[off] = (bf16)(cvtpk(v, 0.f) & 0xffffu); }
        }
        __syncthreads();
    }
}

constexpr int NSA_KS = 0, NSA_VS = 16384, NSA_IMP = 32768, NSA_SELM = NSA_IMP + 64 * 129 * 4, NSA_BT = NSA_SELM + 1024, NSA_END = NSA_BT + 2048;
static_assert(NSA_END <= RING_BYTES && NSA_SELM % 16 == 0, "nsa lds map");

template <int MODE>
__device__ __forceinline__ void nsa_tiles(LAS unsigned char* lds, const unsigned char* Kimg, const unsigned char* Vimg, int jt0, int jt1, const bf16x8 (&q)[4], int wave, int lane, int tq, int cur, int hd, int qi,
                                          float& m, float& l, att::f32x16 (&o)[2], float invl) {
    using namespace att;
    const int r = lane & 31, hh = lane >> 5;
    LAS unsigned char* Ks = lds + NSA_KS; LAS unsigned char* Vs = lds + NSA_VS;
    const LAS float* BT = (const LAS float*)(lds + NSA_BT) + hd * 128;
    LAS unsigned* IMP = (LAS unsigned*)(lds + NSA_IMP);
    const LAS unsigned* SELM = (const LAS unsigned*)(lds + NSA_SELM);
    const float C2 = 0.125f * LOG2E;
    dma_tile<8192>(Kimg + (size_t)jt0 * 8192, Ks, wave, lane);
    if (MODE != 0) dma_tile<8192>(Vimg + (size_t)jt0 * 8192, Vs, wave, lane);
#pragma unroll 1
    for (int jt = jt0; jt <= jt1; ++jt) {
        const int sl = (jt - jt0) & 1;
        asm volatile("s_waitcnt vmcnt(0)" ::: "memory"); __syncthreads();
        if (jt < jt1) { dma_tile<8192>(Kimg + (size_t)(jt + 1) * 8192, Ks + (sl ^ 1) * 8192, wave, lane); if (MODE != 0) dma_tile<8192>(Vimg + (size_t)(jt + 1) * 8192, Vs + (sl ^ 1) * 8192, wave, lane); }
        f32x16 p0, p1;
        qk_tile<64>(p0, p1, (lcp)(Ks + sl * 8192), q, r, hh);
        if (MODE == 0 || MODE == 1) {
            const int db = tq - 31 - 16 * (64 * jt + 4 * hh);
#pragma unroll
            for (int i = 0; i < 16; ++i) { const int ko = (i & 3) + 8 * (i >> 2);
                const int d0 = db - 16 * ko, d1 = d0 - 512;
                p0[i] = d0 >= 0 ? p0[i] * C2 + BT[d0 > 127 ? 127 : d0] : NEG_BIG;
                p1[i] = d1 >= 0 ? p1[i] * C2 + BT[d1 > 127 ? 127 : d1] : NEG_BIG; }
        } else {
            const int db = tq - (64 * jt + 4 * hh);
            bool selb = true;
            if (MODE == 2) selb = (SELM[qi * 4 + (jt >> 5)] >> (jt & 31)) & 1u;
            if (MODE == 3 || jt >= cur - 2) {
#pragma unroll
                for (int i = 0; i < 16; ++i) { const int ko = (i & 3) + 8 * (i >> 2);
                    const int d0 = db - ko, d1 = d0 - 32;
                    const bool v0 = selb && d0 >= 0 && (MODE != 3 || d0 < 512), v1 = selb && d1 >= 0 && (MODE != 3 || d1 < 512);
                    p0[i] = v0 ? p0[i] * C2 + BT[d0 > 127 ? 127 : d0] : NEG_BIG;
                    p1[i] = v1 ? p1[i] * C2 + BT[d1 > 127 ? 127 : d1] : NEG_BIG; }
            } else {
                const float b31 = BT[127];
#pragma unroll
                for (int i = 0; i < 16; ++i) { p0[i] = selb ? p0[i] * C2 + b31 : NEG_BIG; p1[i] = selb ? p1[i] * C2 + b31 : NEG_BIG; }
            }
        }
        if (MODE == 0) {
            float mx = fmaxf(p0[0], p1[0]);
#pragma unroll
            for (int i = 1; i < 16; ++i) mx = fmaxf(mx, fmaxf(p0[i], p1[i]));
            mx = xhalf_max(mx);
            const float mn = fmaxf(m, mx); float s = 0.f;
#pragma unroll
            for (int i = 0; i < 16; ++i) { s += (p0[i] > -1.0e29f ? __builtin_amdgcn_exp2f(p0[i] - mn) : 0.f) + (p1[i] > -1.0e29f ? __builtin_amdgcn_exp2f(p1[i] - mn) : 0.f); }
            l = l * __builtin_amdgcn_exp2f(m - mn) + s; m = mn;
        } else if (MODE == 1) {
#pragma unroll
            for (int i = 0; i < 16; ++i) { p0[i] = p0[i] > -1.0e29f ? __builtin_amdgcn_exp2f(p0[i] - m) * invl : 0.f; p1[i] = p1[i] > -1.0e29f ? __builtin_amdgcn_exp2f(p1[i] - m) * invl : 0.f; }
#pragma unroll
            for (int i4 = 0; i4 < 4; ++i4) {
#pragma unroll
                for (int pp = 0; pp < 2; ++pp) {
                    const float x0 = pp ? p1[4 * i4] : p0[4 * i4], x1 = pp ? p1[4 * i4 + 1] : p0[4 * i4 + 1], x2 = pp ? p1[4 * i4 + 2] : p0[4 * i4 + 2], x3 = pp ? p1[4 * i4 + 3] : p0[4 * i4 + 3];
                    const int js = 16 * jt + 8 * pp + 2 * i4 + hh;
                    const float a = (x0 + x1) + (x2 + 0.5f * x3), bq = 0.5f * x3;
                    if (a > 0.f) { __hip_atomic_fetch_add(IMP + qi * 129 + js, (unsigned)(a * 16777216.f + 0.5f), __ATOMIC_RELAXED, __HIP_MEMORY_SCOPE_WORKGROUP);
                        if (js + 1 < 128 && bq > 0.f) __hip_atomic_fetch_add(IMP + qi * 129 + js + 1, (unsigned)(bq * 16777216.f + 0.5f), __ATOMIC_RELAXED, __HIP_MEMORY_SCOPE_WORKGROUP); }
                }
            }
            pv_tile<64>(o, (lcp)(Vs + sl * 8192), p0, p1, lane);
        } else {
            softmax_step<2>(p0, p1, m, l, o);
            pv_tile<64>(o, (lcp)(Vs + sl * 8192), p0, p1, lane);
        }
    }
    __syncthreads();
}

__device__ __forceinline__ unsigned wave_max_u32(unsigned v) {
#pragma unroll
    for (int o = 1; o < 64; o <<= 1) { const unsigned t = (unsigned)__shfl_xor((int)v, o); v = t > v ? t : v; }
    return v;
}

__device__ __forceinline__ void nsa_phase(Frame& F, const Args& a) {
    using namespace att;
    const int lane = F.lane, r = lane & 31, hh = lane >> 5, wave = F.wave, hd = wave & 3, half = wave >> 2;
    LAS unsigned* IMP = (LAS unsigned*)(F.lds + RING_OFF + NSA_IMP); LAS unsigned* SELM = (LAS unsigned*)(F.lds + RING_OFF + NSA_SELM); LAS float* BTw = (LAS float*)(F.lds + RING_OFF + NSA_BT);
    const float* tab = (const float*)(a.ws + WS_TAB);
    const bf16* Q = (const bf16*)(a.ws + WS_Q); const float* GATES = (const float*)(a.ws + WS_GATES); bf16* MIX = (bf16*)(a.ws + WS_MIX);
#pragma unroll 1
    for (int it = 0; it * F.G + F.vcu < 1024; ++it) {
        int bg, cur;
        if (F.G == 256) { const int s = F.vcu & 31; bg = F.vcu >> 5; cur = it == 0 ? s : (it == 1 ? 63 - s : (it == 2 ? 64 + s : 127 - s)); }
        else { const int u = it * F.G + F.vcu; bg = u >> 7; cur = u & 127; }
        const int b = bg >> 2, g = bg & 3, h = 4 * g + hd, qi = 32 * half + r, tq = 64 * cur + qi;
        const size_t rowq = (size_t)b * SEQ + tq;
        bf16x8 q[4];
#pragma unroll
        for (int ks = 0; ks < 4; ++ks) q[ks] = *(const bf16x8*)(Q + rowq * 1024 + h * 64 + 16 * ks + 8 * hh);
        const float gc = GATES[rowq * 48 + h], gs = GATES[rowq * 48 + 16 + h], gw = GATES[rowq * 48 + 32 + h];
        for (int i = F.tid; i < 64 * 129; i += NWAVES * 64) IMP[i] = 0u;
        BTw[F.tid] = tab[TAB_BIAS2 / 4 + (4 * g) * 128 + F.tid];
        __syncthreads();
        const unsigned char* slab = a.ws + WS_KV + (size_t)bg * 8192 * 64 * 2;
        constexpr size_t SLAB = (size_t)8 * 8192 * 64 * 2;
        f32x16 ot[2]; ot[0] = (f32x16){0.f}; ot[1] = ot[0];
        {
            const unsigned char* Kc = a.ws + WS_KCI + (size_t)bg * 65536; const unsigned char* Vc = a.ws + WS_VCI + (size_t)bg * 65536;
            const int nct = (4 * cur + 2) / 64;
            float m = NEG_BIG, l = 0.f; f32x16 oc[2]; oc[0] = (f32x16){0.f}; oc[1] = oc[0];
            nsa_tiles<0>(F.lds + RING_OFF, Kc, Vc, 0, nct, q, wave, lane, tq, cur, hd, qi, m, l, oc, 0.f);
            l = xhalf_sum(l); const float invl = l > 0.f ? 1.f / l : 0.f;
            nsa_tiles<1>(F.lds + RING_OFF, Kc, Vc, 0, nct, q, wave, lane, tq, cur, hd, qi, m, l, oc, invl);
            ot[0] = oc[0] * gc; ot[1] = oc[1] * gc;
        }
#pragma unroll 1
        for (int qq = 0; qq < 8; ++qq) {
            const int qs = wave * 8 + qq;
            unsigned long long mA = 0ull, mB = 0ull;
            if (cur < 16) { mA = (cur == 63) ? ~0ull : ((1ull << (cur + 1)) - 1ull); }
            else {
                const int ja = lane, jb = lane + 64;
                unsigned ka = IMP[qs * 129 + ja], kb = IMP[qs * 129 + jb];
                ka = (ja == 0 || ja == cur || ja == cur - 1) ? 0u : (ja <= cur ? ka + 1u : 0u);
                kb = (jb == cur || jb == cur - 1) ? 0u : (jb <= cur ? kb + 1u : 0u);
                mA = 1ull; if (cur < 64) mA |= 1ull << cur; else mB |= 1ull << (cur - 64);
                if (cur - 1 < 64) mA |= 1ull << (cur - 1); else mB |= 1ull << (cur - 1 - 64);
#pragma unroll 1
                for (int k = 0; k < 13; ++k) {
                    const unsigned mx = wave_max_u32(ka > kb ? ka : kb);
                    if (mx == 0u) break;
                    const unsigned long long ba = __ballot(ka == mx);
                    if (ba) { const int idx = __ffsll((long long)ba) - 1; mA |= 1ull << idx; if (lane == idx) ka = 0u; }
                    else { const unsigned long long bb = __ballot(kb == mx); const int idx = __ffsll((long long)bb) - 1; mB |= 1ull << idx; if (lane == idx) kb = 0u; }
                }
            }
            if (lane == 0) { SELM[qs * 4 + 0] = (unsigned)mA; SELM[qs * 4 + 1] = (unsigned)(mA >> 32); SELM[qs * 4 + 2] = (unsigned)mB; SELM[qs * 4 + 3] = (unsigned)(mB >> 32); }
        }
        __syncthreads();
        {
            float m = NEG_BIG, l = 0.f; f32x16 os[2]; os[0] = (f32x16){0.f}; os[1] = os[0];
            nsa_tiles<2>(F.lds + RING_OFF, slab + 2 * SLAB, slab + 3 * SLAB, 0, cur, q, wave, lane, tq, cur, hd, qi, m, l, os, 0.f);
            l = xhalf_sum(l); const float sc = gs / l;
            ot[0] += os[0] * sc; ot[1] += os[1] * sc;
        }
        {
            float m = NEG_BIG, l = 0.f; f32x16 ow[2]; ow[0] = (f32x16){0.f}; ow[1] = ow[0];
            nsa_tiles<3>(F.lds + RING_OFF, slab + 4 * SLAB, slab + 5 * SLAB, cur >= 8 ? cur - 8 : 0, cur, q, wave, lane, tq, cur, hd, qi, m, l, ow, 0.f);
            l = xhalf_sum(l); const float sc = gw / l;
            ot[0] += ow[0] * sc; ot[1] += ow[1] * sc;
        }
        bf16* orow = MIX + rowq * MIXW + h * 64 + 4 * hh;
#pragma unroll
        for (int d0 = 0; d0 < 2; ++d0)
#pragma unroll
            for (int i4 = 0; i4 < 4; ++i4) { typedef unsigned u32x2 __attribute__((ext_vector_type(2)));
                u32x2 w; w.x = cvtpk(ot[d0][4 * i4], ot[d0][4 * i4 + 1]); w.y = cvtpk(ot[d0][4 * i4 + 2], ot[d0][4 * i4 + 3]);
                *(u32x2*)(orow + 32 * d0 + 8 * i4) = w; }
    }
}
__device__ __forceinline__ void p0_item(const float* __restrict__ W, int K, int srcN, int sc0, int nvalid, const float* __restrict__ gvec, bf16* __restrict__ WT, int n0, int k0, LAS float* scr, int lane) {
    const bool ok = (lane & 31) < nvalid;
#pragma unroll 8
    for (int i = 0; i < 32; ++i) { const int kk = 2 * i + (lane >> 5); float v = ok ? W[(size_t)(k0 + kk) * srcN + sc0 + (lane & 31)] : 0.f; if (gvec) v *= gvec[k0 + kk]; scr[kk * 33 + (lane & 31)] = v; }
    LDS_WAIT(); asm volatile("" ::: "memory");
    const int c = lane & 7;
#pragma unroll
    for (int j = 0; j < 4; ++j) { const int n = (lane >> 3) + 8 * j; const LAS float* s = scr + (8 * c) * 33 + n;
        v4u o; o.x = pk2(s[0 * 33], s[1 * 33]); o.y = pk2(s[2 * 33], s[3 * 33]); o.z = pk2(s[4 * 33], s[5 * 33]); o.w = pk2(s[6 * 33], s[7 * 33]);
        *(GAS v4u*)(WT + (size_t)(n0 + n) * K + k0 + 8 * c) = o; }
    LDS_WAIT(); asm volatile("" ::: "memory");
}
__device__ __forceinline__ int map_conv(int n) { const int pn = n >> 8, r = n & 255; if (pn < 4 || pn >= 12) return n; const int i = pn - 4; return r < 128 ? 1024 + 128 * i + r : 2048 + 128 * i + (r - 128); }
__device__ __forceinline__ int map_ffi(int n) { const int pn = n >> 8, r = n & 255; return r < 128 ? 128 * pn + r : FFH + 128 * pn + (r - 128); }
__device__ __forceinline__ void map_nsa(int n, int& sc, int& nv) { nv = 32; if (n < 2560) sc = n; else if (n < 3072) sc = 2608 + (n - 2560); else if (n < 3120) { sc = 2560 + (n - 3072); nv = (3120 - n) < 32 ? (3120 - n) : 32; } else { sc = 0; nv = 0; } }

__device__ __forceinline__ void p0_prologue(Frame& F, const Args& a) {
    LAS float* scr = (LAS float*)(F.lds + RING_OFF + F.wave * 16384);
    const int gw = F.vcu * NWAVES + F.wave, NGW = F.G * NWAVES;
    unsigned char* ws = a.ws;
    constexpr int I_CONV = 16 * (CONV_N / 32), I_NSA = 16 * (NSA_N / 32), I_OUT = 24 * 32, I_FFI = 16 * 176, I_FFO = 44 * 32, I_MKV = 16 * 32, I_C1 = 32 * 4, I_C2 = 2 * 2;
    constexpr int NITEMS = I_CONV + I_NSA + 2 * I_OUT + 2 * I_FFI + 2 * I_FFO + 2 * I_MKV + 2 * I_C1 + 2 * I_C2;
    for (int it = gw; it < NITEMS; it += NGW) {
        int r = it;
        if (r < I_CONV) { const int nb = r % (CONV_N / 32), kb = r / (CONV_N / 32); p0_item(a.in[6], 1024, CONV_N, map_conv(32 * nb), 32, a.in[2], (bf16*)(ws + WS_WCONV), 32 * nb, 64 * kb, scr, F.lane); continue; } r -= I_CONV;
        if (r < I_NSA) { const int nb = r % (NSA_N / 32), kb = r / (NSA_N / 32); int sc, nv; map_nsa(32 * nb, sc, nv); p0_item(a.in[8], 1024, NSA_SRC, sc, nv, a.in[2] + DM, (bf16*)(ws + WS_WNSA), 32 * nb, 64 * kb, scr, F.lane); continue; } r -= I_NSA;
        if (r < 2 * I_OUT) { const int l = r / I_OUT; r -= l * I_OUT; const int nb = r % 32, kb = r / 32; p0_item(a.in[17] + (size_t)l * MIXW * DM, MIXW, DM, 32 * nb, 32, nullptr, (bf16*)(ws + WS_WOUT) + (size_t)l * DM * MIXW, 32 * nb, 64 * kb, scr, F.lane); continue; } r -= 2 * I_OUT;
        if (r < 2 * I_FFI) { const int l = r / I_FFI; r -= l * I_FFI; const int nb = r % 176, kb = r / 176; p0_item(a.in[18] + (size_t)l * DM * 2 * FFH, DM, 2 * FFH, map_ffi(32 * nb), 32, a.in[4] + l * DM, (bf16*)(ws + WS_WFFI) + (size_t)l * 2 * FFH * DM, 32 * nb, 64 * kb, scr, F.lane); continue; } r -= 2 * I_FFI;
        if (r < 2 * I_FFO) { const int l = r / I_FFO; r -= l * I_FFO; const int nb = r % 32, kb = r / 32; p0_item(a.in[19] + (size_t)l * FFH * DM, FFH, DM, 32 * nb, 32, nullptr, (bf16*)(ws + WS_WFFO) + (size_t)l * DM * FFH, 32 * nb, 64 * kb, scr, F.lane); continue; } r -= 2 * I_FFO;
        if (r < 2 * I_MKV) { const int l = r / I_MKV; r -= l * I_MKV; const int nb = r % 32, kb = r / 32; p0_item(a.in[16] + (size_t)l * DM * 1024, DM, 1024, 32 * nb, 32, nullptr, (bf16*)(ws + WS_WMKV) + (size_t)l * 1024 * DM, 32 * nb, 64 * kb, scr, F.lane); continue; } r -= 2 * I_MKV;
        if (r < 2 * I_C1) { const int l = r / I_C1; r -= l * I_C1; const int nb = r % 4, kb = r / 4; p0_item(a.in[l ? 13 : 10], 2048, 128, 32 * nb, 32, nullptr, (bf16*)(ws + WS_WC1) + (size_t)l * 128 * 2048, 32 * nb, 64 * kb, scr, F.lane); continue; } r -= 2 * I_C1;
        { const int l = r / I_C2; r -= l * I_C2; const int nb = r % 2, kb = r / 2; p0_item(a.in[l ? 14 : 11], 128, 64, 32 * nb, 32, nullptr, (bf16*)(ws + WS_WC2) + (size_t)l * 64 * 128, 32 * nb, 64 * kb, scr, F.lane); }
    }
    bf16* XN = (bf16*)(ws + WS_XN); float* ST = (float*)(ws + WS_STATS);
    for (int m = gw; m < MTOK; m += NGW) {
        const GAS f32x4* xr = (const GAS f32x4*)(a.in[0] + (size_t)m * DM) + F.lane; f32x4 v[4]; float s = 0.f;
#pragma unroll
        for (int j = 0; j < 4; ++j) { v[j] = xr[64 * j]; s += (v[j].x * v[j].x + v[j].y * v[j].y) + (v[j].z * v[j].z + v[j].w * v[j].w); }
        s = wave_sum(s);
        GAS unsigned long long* o8 = (GAS unsigned long long*)(XN + (size_t)m * DM) + F.lane;
#pragma unroll
        for (int j = 0; j < 4; ++j) o8[64 * j] = (unsigned long long)pk2(v[j].x, v[j].y) | ((unsigned long long)pk2(v[j].z, v[j].w) << 32);
        if (F.lane < 16) ST[(size_t)m * 16 + F.lane] = F.lane == 0 ? s : 0.f;
    }
    bf16* MEMN = (bf16*)(ws + WS_MEMN);
    for (int r = gw; r < 2 * BATCH * NMEM; r += NGW) { const int l = r / (BATCH * NMEM), row = r % (BATCH * NMEM);
        const GAS f32x4* xr = (const GAS f32x4*)(a.in[1] + (size_t)row * DM) + F.lane; const GAS f32x4* gr = (const GAS f32x4*)(a.in[3] + (size_t)l * DM) + F.lane; f32x4 v[4]; float s = 0.f;
#pragma unroll
        for (int j = 0; j < 4; ++j) { v[j] = xr[64 * j]; s += (v[j].x * v[j].x + v[j].y * v[j].y) + (v[j].z * v[j].z + v[j].w * v[j].w); }
        const float rs = rsqrtf(wave_sum(s) * (1.f / DM) + 1e-6f);
        GAS unsigned long long* o8 = (GAS unsigned long long*)(MEMN + (size_t)r * DM) + F.lane;
#pragma unroll
        for (int j = 0; j < 4; ++j) { const f32x4 g = gr[64 * j]; o8[64 * j] = (unsigned long long)pk2(v[j].x * rs * g.x, v[j].y * rs * g.y) | ((unsigned long long)pk2(v[j].z * rs * g.z, v[j].w * rs * g.w) << 32); }
    }
}
__device__ __forceinline__ void p_final(Frame& F, const Args& a) {
    const int gw = F.vcu * NWAVES + F.wave, NGW = F.G * NWAVES; const float* ST = (const float*)(a.ws + WS_STATS);
    for (int m = gw; m < MTOK; m += NGW) {
        const float rs = pg8::row_rstd(ST, m);
        GAS f32x4* xr = (GAS f32x4*)(a.out + (size_t)m * DM) + F.lane; const GAS f32x4* gr = (const GAS f32x4*)(a.in[5]) + F.lane;
#pragma unroll
        for (int j = 0; j < 4; ++j) xr[64 * j] = xr[64 * j] * rs * gr[64 * j];
    }
}

__global__ void __launch_bounds__(NWAVES * 64, 2) mega_fwd(Args args) {
    extern __shared__ __attribute__((aligned(16))) unsigned char lds[];
    Frame F;
    F.lds = (LAS unsigned char*)lds;
    F.MISC = (volatile LAS unsigned*)(F.lds + MISC_OFF);
    F.tid = threadIdx.x; F.lane = F.tid & 63; F.wave = __builtin_amdgcn_readfirstlane(F.tid >> 6);
    F.G = gridDim.x; { const int bx = blockIdx.x; F.vcu = (F.G % 8 == 0) ? (bx % 8) * (F.G / 8) + bx / 8 : bx; }
    unsigned char* ws = args.ws;
    F.ctl = (gu32*)(ws + WS_CTL);
    for (int u = F.tid; u < (LDS_BYTES - LDSCTL_OFF) / 4; u += NWAVES * 64) ((LAS unsigned*)(F.lds + LDSCTL_OFF))[u] = 0u;
    __syncthreads();
    const int lo = args.ph_lo, hi = args.ph_hi;
    XcdBarrier bar; bar.bar = (unsigned*)(F.ctl + CW_BAR) + args.li * XCD_BAR_WORDS; bar.x = 0; bar.st = nullptr;
    if (hi - lo > 1) bar = xcd_barrier_post((unsigned*)(F.ctl + CW_BAR) + args.li * XCD_BAR_WORDS, F.MISC + 8);
#ifndef PHMASK
#define PHMASK 0xFFFF
#endif
#define IN(k) (((PHMASK >> (k)) & 1) && lo <= (k) && (k) < hi)
#define SEAM(k) do { if (IN(k) && IN((k) + 1)) xcd_barrier(bar); } while (0)
    bf16* XN = (bf16*)(ws + WS_XN); bf16* MIX = (bf16*)(ws + WS_MIX); float* ST = (float*)(ws + WS_STATS);
    float* H = args.out;

    if (IN(0)) { p0_tables(F, args); p0_prologue(F, args); } SEAM(0);
    if (IN(1)) {
        if (blockIdx.x >= 128) {
            pg8::Gemm g{(const bf16*)(ws + WS_MEMN), (const bf16*)(ws + WS_WMKV), 1024, 2048, DM, DM}; pg8::DiagOrder S{128, (int)blockIdx.x - 128};
            pg8::EpiMemKV E{(bf16*)(ws + WS_MKI), (bf16*)(ws + WS_MVI)};
            pg8::gemm_phase<pg8::EpiMemKV, pg8::DiagOrder, true, true>(F.lds + RING_OFF, g, S, E);
        }
        pg8::Gemm g{XN, (const bf16*)(ws + WS_WCONV), MTOK, CONV_N, DM, DM}; pg8::StaticOrder S; S.init(MTOK, CONV_N, F.G, (int)blockIdx.x);
        pg8::EpiConv E{(bf16*)(ws + WS_UB), (bf16*)(ws + WS_V), (bf16*)(ws + WS_XQ0), ST};
        pg8::gemm_phase<pg8::EpiConv, pg8::StaticOrder, true, true>(F.lds + RING_OFF, g, S, E);
    } SEAM(1);
    if (IN(2)) { conv_phase(F, args); memattn_phase(F, args, 0, (const bf16*)(ws + WS_XQ0)); }
    SEAM(2);
#define LAYER_TAIL(l, pb) \
        if (IN(pb)) { \
            pg8::Gemm g{MIX, (const bf16*)(ws + WS_WOUT) + (size_t)(l) * DM * MIXW, MTOK, DM, MIXW, MIXW}; pg8::StaticOrder S; S.init(MTOK, DM, F.G, (int)blockIdx.x); \
            pg8::EpiRes E{(l) ? H : args.in[0], H, XN, ST}; \
            pg8::gemm_phase<pg8::EpiRes, pg8::StaticOrder, true, true>(F.lds + RING_OFF, g, S, E); \
        } SEAM(pb); \
        if (IN((pb) + 1)) { \
            pg8::Gemm g{XN, (const bf16*)(ws + WS_WFFI) + (size_t)(l) * 2 * FFH * DM, MTOK, 2 * FFH, DM, DM}; pg8::StaticOrder S; S.init(MTOK, 2 * FFH, F.G, (int)blockIdx.x); \
            pg8::EpiSwiglu E{(bf16*)(ws + WS_HID), ST}; \
            pg8::gemm_phase<pg8::EpiSwiglu, pg8::StaticOrder, true, true>(F.lds + RING_OFF, g, S, E); \
        } SEAM((pb) + 1); \
        if (IN((pb) + 2)) { \
            pg8::Gemm g{(const bf16*)(ws + WS_HID), (const bf16*)(ws + WS_WFFO) + (size_t)(l) * DM * FFH, MTOK, DM, FFH, FFH}; pg8::StaticOrder S; S.init(MTOK, DM, F.G, (int)blockIdx.x); \
            pg8::EpiRes E{H, H, XN, ST}; \
            pg8::gemm_phase<pg8::EpiRes, pg8::StaticOrder, true, true>(F.lds + RING_OFF, g, S, E); \
        } SEAM((pb) + 2);
    LAYER_TAIL(0, 3)
    if (IN(6)) {
        pg8::Gemm g{XN, (const bf16*)(ws + WS_WNSA), MTOK, NSA_N, DM, DM}; pg8::StaticOrder S; S.init(MTOK, NSA_N, F.G, (int)blockIdx.x);
        pg8::EpiNsa E{(bf16*)(ws + WS_Q), (bf16*)(ws + WS_KV), (bf16*)(ws + WS_XQ1), (float*)(ws + WS_GATES), ST};
        pg8::gemm_phase<pg8::EpiNsa, pg8::StaticOrder, true, true>(F.lds + RING_OFF, g, S, E);
    } SEAM(6);
    if (IN(7)) { cmpmlp_phase(F, args); memattn_phase(F, args, 1, (const bf16*)(ws + WS_XQ1)); } SEAM(7);
    if (IN(8)) { nsa_phase(F, args); } SEAM(8);
    LAYER_TAIL(1, 9)
#undef LAYER_TAIL
    if (IN(12)) p_final(F, args);
#undef IN
#undef SEAM
}

static void launch_mega(const Args& base, int lo, int hi, int grid, hipStream_t stream, int li = 0) {
    Args a = base; a.ph_lo = lo; a.ph_hi = hi; a.li = li;
    hipLaunchKernelGGL(mega_fwd, dim3(grid), dim3(NWAVES * 64), LDS_BYTES, stream, a);
}
extern "C" void kernel_launch(void* const* d_in, const int* in_sizes, int n_in, void* d_out, int out_size, void* d_ws, size_t ws_size, hipStream_t stream) {
    static int grid = 0;
    if (grid == 0) {
        int dev = 0, cus = 0;
        if (n_in != 20 || out_size != MTOK * DM || ws_size < WS_END) { fprintf(stderr, "kernel_launch: unexpected shapes (n_in %d out %d ws %zu)\n", n_in, out_size, ws_size); grid = -1; return; }
        if (hipGetDevice(&dev) != hipSuccess || hipDeviceGetAttribute(&cus, hipDeviceAttributeMultiprocessorCount, dev) != hipSuccess) { grid = -1; return; }
        if (hipFuncSetAttribute((const void*)mega_fwd, hipFuncAttributeMaxDynamicSharedMemorySize, LDS_BYTES) != hipSuccess) { fprintf(stderr, "kernel_launch: hipFuncSetAttribute failed\n"); grid = -1; return; }
        grid = cus;
    }
    if (grid < 0) return;
    (void)hipMemsetAsync((char*)d_ws + WS_CTL, 0, CTL_ZERO_BYTES, stream);
    Args a{};
    for (int i = 0; i < 20; ++i) a.in[i] = (const float*)d_in[i];
    a.out = (float*)d_out; a.ws = (unsigned char*)d_ws;
    launch_mega(a, 0, 13, grid, stream, 0);
}
```

```cpp
#include <hip/hip_runtime.h>
#include <cstdio>
#include <cstdint>
#include <cmath>

namespace pg8 {
#define PG8_LAS __attribute__((address_space(3)))
typedef unsigned short bf16_t;
typedef short bf16x8 __attribute__((ext_vector_type(8)));
typedef float f32x4 __attribute__((ext_vector_type(4)));
typedef unsigned u32x4 __attribute__((ext_vector_type(4)));
constexpr int BM = 256, BK = 64, HALF = 128, HTB = HALF * BK * 2  , STAGE_BYTES = 8 * HTB, NXCD = 8, WGM = 8;

__host__ __device__ __forceinline__ int lds_byte(int r, int c) { const int st = (r >> 4) * 2 + (c >> 5), rr = r & 15, cc = c & 31, ob = rr * 64 + cc * 2; return st * 1024 + (ob ^ (((ob >> 9) & 1) << 5)); }
__host__ __device__ __forceinline__ void stage_rc(int b, int& R, int& C) { const int st = b / 1024, sb = b % 1024, swz = sb ^ (((sb >> 9) & 1) << 5); R = (st >> 1) * 16 + swz / 64; C = (st & 1) * 32 + (swz % 64) / 2; }
__host__ __device__ __forceinline__ int perm32(int rho) { const int n = rho >> 4, i = rho & 15; return 8 * (i >> 2) + 4 * n + (i & 3); }

struct Unit { int pm, pn; };
struct Gemm { const bf16_t* A; const bf16_t* Bt; int M, N, K, lda; };

struct StaticOrder {
    int nM, nN, nwg, G, c;
    __host__ __device__ void init(int M, int N, int G_, int c_) { nM = M / BM; nN = N / BM; nwg = nM * nN; G = G_; c = c_; }
    __host__ __device__ bool next(int i, Unit& u) const {
        const long L = (long)i * G + c; if (L >= nwg) return false;
        int wgid = (int)L; { const int q = nwg / NXCD, r = nwg % NXCD, xcd = wgid % NXCD, off = wgid / NXCD; wgid = (xcd < r ? xcd * (q + 1) : r * (q + 1) + (xcd - r) * q) + off; }
        const int nig = WGM * nN, gid = wgid / nig, fm = gid * WGM, gsz = (nM - fm) < WGM ? (nM - fm) : WGM;
        u.pm = fm + ((wgid % nig) % gsz); u.pn = (wgid % nig) / gsz; return true;
    }
    __device__ __forceinline__ void a_ready(const Unit&) const {}
    __device__ __forceinline__ void done(const Unit&) const {}
};


__device__ __forceinline__ unsigned cvt_pk_bf16(float lo, float hi) { unsigned r; asm volatile("v_cvt_pk_bf16_f32 %0, %1, %2" : "=v"(r) : "v"(lo), "v"(hi)); return r; }
__device__ __forceinline__ u32x4 pack8(const f32x4 v0, const f32x4 v1) { u32x4 w; w.x = cvt_pk_bf16(v0[0], v0[1]); w.y = cvt_pk_bf16(v0[2], v0[3]); w.z = cvt_pk_bf16(v1[0], v1[1]); w.w = cvt_pk_bf16(v1[2], v1[3]); return w; }
__device__ __forceinline__ float row_rstd(const float* __restrict__ stats, int row) {
    const f32x4* s = (const f32x4*)(stats + (size_t)row * 16);
    const f32x4 a = s[0], b = s[1], c = s[2], d = s[3];
    const float t = ((a[0] + a[1]) + (a[2] + a[3])) + ((b[0] + b[1]) + (b[2] + b[3])) + ((c[0] + c[1]) + (c[2] + c[3])) + ((d[0] + d[1]) + (d[2] + d[3]));
    return rsqrtf(t * (1.0f / 1024.0f) + 1e-6f);
}
__device__ __forceinline__ float silu_f(float g) { return g * __builtin_amdgcn_rcpf(1.0f + __builtin_amdgcn_exp2f(-1.4426950408889634f * g)); }
__device__ __forceinline__ float sigm_f(float g) { return __builtin_amdgcn_rcpf(1.0f + __builtin_amdgcn_exp2f(-1.4426950408889634f * g)); }

struct EpiMemKV {
    static constexpr bool PERM = true, AFTER_DRAIN = false;
    bf16_t* MK; bf16_t* MV;
    __device__ __forceinline__ void operator()(const f32x4 (&acc)[2][2][4][2], const Unit& u, int wr, int wc, int fr, int fq) const {
        const int la = u.pm >> 1, b = u.pm & 1, kv = (u.pn >> 1) & 1;
#pragma unroll
        for (int ai = 0; ai < 2; ++ai)
#pragma unroll
            for (int m = 0; m < 4; ++m) { const int key = ai * HALF + wr * 64 + m * 16 + fr;
#pragma unroll
                for (int bj = 0; bj < 2; ++bj) { const int head = (u.pn & 1) * 2 + bj, d = wc * 32 + 8 * fq;
                    bf16_t* base = (kv ? MV : MK) + (size_t)((la * 2 + b) * 4 + head) * 32768;
                    const size_t off = kv ? (size_t)(key >> 6) * 8192 + (d >> 5) * 2048 + (key & 63) * 32 + (d & 31) : (size_t)(key >> 6) * 8192 + (d >> 3) * 512 + (key & 63) * 8;
                    *(u32x4*)(base + off) = pack8(acc[ai][bj][m][0], acc[ai][bj][m][1]); } }
    }
};
struct DiagOrder {
    int G, c;
    __device__ bool next(int i, Unit& u) const { const int L = i * G + c; if (L >= 16) return false; const int la = L >> 3; u.pm = la * 2 + ((L >> 2) & 1); u.pn = la * 4 + (L & 3); return true; }
    __device__ __forceinline__ void a_ready(const Unit&) const {}
    __device__ __forceinline__ void done(const Unit&) const {}
};
struct EpiConv {
    static constexpr bool PERM = true, AFTER_DRAIN = false;
    bf16_t* UB; bf16_t* V; bf16_t* XQ; const float* stats;
    __device__ __forceinline__ void operator()(const f32x4 (&acc)[2][2][4][2], const Unit& u, int wr, int wc, int fr, int fq) const {
#pragma unroll
        for (int ai = 0; ai < 2; ++ai)
#pragma unroll
            for (int m = 0; m < 4; ++m) { const int row = u.pm * BM + ai * HALF + wr * 64 + m * 16 + fr; const float rs = row_rstd(stats, row);
                if (u.pn < 4) {
#pragma unroll
                    for (int bj = 0; bj < 2; ++bj) *(u32x4*)(UB + (size_t)row * 1024 + u.pn * BM + bj * HALF + wc * 32 + 8 * fq) = pack8(acc[ai][bj][m][0] * rs, acc[ai][bj][m][1] * rs);
                } else if (u.pn < 12) {
                    const float r2 = rs * rs;
                    *(u32x4*)(V + (size_t)row * 1024 + (u.pn - 4) * HALF + wc * 32 + 8 * fq) = pack8(acc[ai][0][m][0] * acc[ai][1][m][0] * r2, acc[ai][0][m][1] * acc[ai][1][m][1] * r2);
                } else {
#pragma unroll
                    for (int bj = 0; bj < 2; ++bj) *(u32x4*)(XQ + (size_t)row * 512 + (u.pn - 12) * BM + bj * HALF + wc * 32 + 8 * fq) = pack8(acc[ai][bj][m][0] * rs, acc[ai][bj][m][1] * rs);
                } }
    }
};
struct EpiSwiglu {
    static constexpr bool PERM = true, AFTER_DRAIN = false;
    bf16_t* HID; const float* stats;
    __device__ __forceinline__ void operator()(const f32x4 (&acc)[2][2][4][2], const Unit& u, int wr, int wc, int fr, int fq) const {
#pragma unroll
        for (int ai = 0; ai < 2; ++ai)
#pragma unroll
            for (int m = 0; m < 4; ++m) { const int row = u.pm * BM + ai * HALF + wr * 64 + m * 16 + fr; const float rs = row_rstd(stats, row);
                f32x4 o[2];
#pragma unroll
                for (int n = 0; n < 2; ++n)
#pragma unroll
                    for (int e = 0; e < 4; ++e) o[n][e] = silu_f(acc[ai][0][m][n][e] * rs) * (acc[ai][1][m][n][e] * rs);
                *(u32x4*)(HID + (size_t)row * 2816 + u.pn * HALF + wc * 32 + 8 * fq) = pack8(o[0], o[1]); }
    }
};
struct EpiNsa {
    static constexpr bool PERM = true, AFTER_DRAIN = false;
    bf16_t* Q; bf16_t* KV; bf16_t* XQ; float* GATES; const float* stats;
    __device__ __forceinline__ void operator()(const f32x4 (&acc)[2][2][4][2], const Unit& u, int wr, int wc, int fr, int fq) const {
#pragma unroll
        for (int ai = 0; ai < 2; ++ai)
#pragma unroll
            for (int m = 0; m < 4; ++m) { const int row = u.pm * BM + ai * HALF + wr * 64 + m * 16 + fr; const float rs = row_rstd(stats, row);
                if (u.pn < 4) {
#pragma unroll
                    for (int bj = 0; bj < 2; ++bj) *(u32x4*)(Q + (size_t)row * 1024 + u.pn * BM + bj * HALF + wc * 32 + 8 * fq) = pack8(acc[ai][bj][m][0] * rs, acc[ai][bj][m][1] * rs);
                } else if (u.pn < 10) {
                    const int b = row >> 13, s = row & 8191;
#pragma unroll
                    for (int bj = 0; bj < 2; ++bj) { const int ct = bj * HALF + wc * 32 + 8 * fq, g = ct >> 6, d = ct & 63, sl = u.pn - 4;
                        const size_t off = sl < 2 ? (size_t)s * 64 + d : ((sl & 1) ? (size_t)(s >> 6) * 4096 + (d >> 5) * 2048 + (s & 63) * 32 + (d & 31) : (size_t)(s >> 6) * 4096 + (d >> 3) * 512 + (s & 63) * 8);
                        *(u32x4*)(KV + ((size_t)sl * 8 + b * 4 + g) * 8192 * 64 + off) = pack8(acc[ai][bj][m][0] * rs, acc[ai][bj][m][1] * rs); }
                } else if (u.pn < 12) {
#pragma unroll
                    for (int bj = 0; bj < 2; ++bj) *(u32x4*)(XQ + (size_t)row * 512 + (u.pn - 10) * BM + bj * HALF + wc * 32 + 8 * fq) = pack8(acc[ai][bj][m][0] * rs, acc[ai][bj][m][1] * rs);
                } else {
                    const int ct = wc * 32 + 8 * fq;
                    if (ct < 48) { f32x4 g0, g1;
#pragma unroll
                        for (int e = 0; e < 4; ++e) { g0[e] = sigm_f(acc[ai][0][m][0][e] * rs); g1[e] = sigm_f(acc[ai][0][m][1][e] * rs); }
                        *(f32x4*)(GATES + (size_t)row * 48 + ct) = g0; *(f32x4*)(GATES + (size_t)row * 48 + ct + 4) = g1; }
                } }
    }
};
struct EpiRes {
    static constexpr bool PERM = true, AFTER_DRAIN = false;
    const float* base; float* out; bf16_t* xn; float* stats;
    __device__ __forceinline__ void operator()(const f32x4 (&acc)[2][2][4][2], const Unit& u, int wr, int wc, int fr, int fq) const {
#pragma unroll
        for (int ai = 0; ai < 2; ++ai)
#pragma unroll
            for (int m = 0; m < 4; ++m) { const int row = u.pm * BM + ai * HALF + wr * 64 + m * 16 + fr; float ss = 0.f;
#pragma unroll
                for (int bj = 0; bj < 2; ++bj) { const size_t off = (size_t)row * 1024 + u.pn * BM + bj * HALF + wc * 32 + 8 * fq;
                    const f32x4 v0 = *(const f32x4*)(base + off) + acc[ai][bj][m][0], v1 = *(const f32x4*)(base + off + 4) + acc[ai][bj][m][1];
                    *(f32x4*)(out + off) = v0; *(f32x4*)(out + off + 4) = v1; *(u32x4*)(xn + off) = pack8(v0, v1);
                    ss += (v0[0] * v0[0] + v0[1] * v0[1]) + (v0[2] * v0[2] + v0[3] * v0[3]) + (v1[0] * v1[0] + v1[1] * v1[1]) + (v1[2] * v1[2] + v1[3] * v1[3]); }
                ss += __shfl_xor(ss, 16); ss += __shfl_xor(ss, 32);
                if (fq == 0) stats[(size_t)row * 16 + u.pn * 4 + wc] = ss; }
    }
};

template <class Epi, class Sched, bool ALIGN_EPI = false, bool SP2 = false>
__device__ __forceinline__ void gemm_phase(PG8_LAS unsigned char* lds, const Gemm g, const Sched& S, const Epi& E) {
    const int tid = threadIdx.x, wid = __builtin_amdgcn_readfirstlane(tid >> 6), lane = tid & 63, wr = wid >> 2, wc = wid & 3, fr = lane & 15, fq = lane >> 4;
    const int K = g.K, nt = K / BK;
    unsigned voffA[2], voffB[2];
#pragma unroll
    for (int i = 0; i < 2; ++i) { int R, C; stage_rc(tid * 16 + i * 8192, R, C); const int Rb = Epi::PERM ? ((R & ~31) + perm32(R & 31)) : R;
        voffA[i] = (unsigned)(R * g.lda + C) * 2u; voffB[i] = (unsigned)(Rb * K + C) * 2u; }
    const size_t kstep = (size_t)(BK * 2);
    const size_t hstepB = (size_t)HALF * K * 2, hstepA = (size_t)HALF * g.lda * 2;
    const size_t tstepB = 2 * hstepB, tstepA = 2 * hstepA;
    const unsigned ldsw = (unsigned)wid * 1024u;
    const int aoff = lds_byte(wr * 64 + fr, fq * 8), boff = lds_byte(wc * 32 + fr, fq * 8);
#define PG8_SA(b, h) (((b) * 2 + (h)) * HTB)
#define PG8_SB(b, h) ((4 + (b) * 2 + (h)) * HTB)
#define PG8_STAGE(bufoff, gbase, voff) do { _Pragma("unroll") for (int _i = 0; _i < 2; ++_i) \
        __builtin_amdgcn_global_load_lds((const unsigned*)((const char*)(gbase) + (voff)[_i]), (PG8_LAS unsigned*)(lds + (bufoff) + ldsw + _i * 8192), 16, 0, 0); } while (0)
#define PG8_LDA(dst, b, h) do { _Pragma("unroll") for (int m = 0; m < 4; ++m) _Pragma("unroll") for (int k = 0; k < 2; ++k) dst[m][k] = *(const PG8_LAS bf16x8*)(lds + PG8_SA(b, h) + aoff + m * 2048 + k * 1024); } while (0)
#define PG8_LDB(dst, b, h) do { _Pragma("unroll") for (int n = 0; n < 2; ++n) _Pragma("unroll") for (int k = 0; k < 2; ++k) dst[n][k] = *(const PG8_LAS bf16x8*)(lds + PG8_SB(b, h) + boff + n * 2048 + k * 1024); } while (0)
#define PG8_MMA(ai, bj, At, Bt) do { __builtin_amdgcn_s_setprio(1); _Pragma("unroll") for (int m = 0; m < 4; ++m) _Pragma("unroll") for (int n = 0; n < 2; ++n) _Pragma("unroll") for (int k = 0; k < 2; ++k) \
        acc[ai][bj][m][n] = __builtin_amdgcn_mfma_f32_16x16x32_bf16(Bt[n][k], At[m][k], acc[ai][bj][m][n], 0, 0, 0); __builtin_amdgcn_s_setprio(0); } while (0)
#define PG8_WAIT_V(n) asm volatile("s_waitcnt vmcnt(" #n ")" ::: "memory")
#define PG8_WAIT_L(n) asm volatile("s_waitcnt lgkmcnt(" #n ")" ::: "memory")
#define PG8_BAR __builtin_amdgcn_s_barrier()
#define PG8_SCHED __builtin_amdgcn_sched_barrier(0)
    Unit cur, nxt; int ui = 0;
    if (!S.next(0, cur)) return;
    f32x4 acc[2][2][4][2];
#pragma unroll
    for (int a = 0; a < 2; ++a)
#pragma unroll
        for (int b = 0; b < 2; ++b)
#pragma unroll
            for (int m = 0; m < 4; ++m)
#pragma unroll
                for (int n = 0; n < 2; ++n) acc[a][b][m][n] = (f32x4){0.f, 0.f, 0.f, 0.f};
    bf16x8 At[4][2], B0[2][2], B1[2][2];
    const char* cA = (const char*)g.A + (size_t)cur.pm * tstepA; const char* cB = (const char*)g.Bt + (size_t)cur.pn * tstepB;
    S.a_ready(cur);
    if constexpr (SP2) {
        PG8_STAGE(PG8_SB(0, 0), cB, voffB); PG8_STAGE(PG8_SB(0, 1), cB + hstepB, voffB); PG8_STAGE(PG8_SA(0, 0), cA, voffA); PG8_STAGE(PG8_SA(0, 1), cA + hstepA, voffA);
        if (wr == 1) PG8_BAR;
        PG8_WAIT_V(2); PG8_BAR;
        PG8_STAGE(PG8_SB(1, 0), cB + kstep, voffB); PG8_STAGE(PG8_SA(1, 0), cA + kstep, voffA); PG8_STAGE(PG8_SB(1, 1), cB + hstepB + kstep, voffB);
        PG8_WAIT_V(6); PG8_BAR;
    } else {
        PG8_STAGE(PG8_SB(0, 0), cB, voffB); PG8_STAGE(PG8_SA(0, 0), cA, voffA); PG8_STAGE(PG8_SB(0, 1), cB + hstepB, voffB); PG8_STAGE(PG8_SA(0, 1), cA + hstepA, voffA);
        if (wr == 1) PG8_BAR;
        PG8_WAIT_V(4); PG8_BAR;
        PG8_STAGE(PG8_SB(1, 0), cB + kstep, voffB); PG8_STAGE(PG8_SA(1, 0), cA + kstep, voffA); PG8_STAGE(PG8_SB(1, 1), cB + hstepB + kstep, voffB);
        PG8_WAIT_V(6); PG8_BAR;
    }
    for (;;) {
        const bool has_next = S.next(ui + 1, nxt);
        const char* nA = has_next ? (const char*)g.A + (size_t)nxt.pm * tstepA : cA; const char* nB = has_next ? (const char*)g.Bt + (size_t)nxt.pn * tstepB : cB;
        for (int t = 0; t < nt; t += 2) {
            const bool last = (t == nt - 2);
            const char* a1 = cA + (size_t)(t + 1) * kstep;
            const char* a2 = last ? nA : cA + (size_t)(t + 2) * kstep; const char* b2 = last ? nB : cB + (size_t)(t + 2) * kstep;
            const char* a3 = a2 + kstep; const char* b3 = b2 + kstep;
            if (last && has_next) S.a_ready(nxt);
            if constexpr (SP2) {
            PG8_LDB(B0, 0, 0); PG8_LDB(B1, 0, 1); PG8_SCHED; PG8_LDA(At, 0, 0); PG8_STAGE(PG8_SA(1, 1), a1 + hstepA, voffA);
            PG8_WAIT_V(8); PG8_WAIT_L(0); PG8_BAR; PG8_MMA(0, 0, At, B0); PG8_MMA(0, 1, At, B1); PG8_BAR; PG8_SCHED;
            PG8_LDA(At, 0, 1); PG8_STAGE(PG8_SB(0, 0), b2, voffB); PG8_STAGE(PG8_SB(0, 1), b2 + hstepB, voffB); PG8_STAGE(PG8_SA(0, 0), a2, voffA);
            PG8_WAIT_V(8); PG8_WAIT_L(0); PG8_BAR; PG8_MMA(1, 0, At, B0); PG8_MMA(1, 1, At, B1); PG8_BAR; PG8_SCHED;
            PG8_LDB(B0, 1, 0); PG8_LDB(B1, 1, 1); PG8_SCHED; PG8_LDA(At, 1, 0); PG8_STAGE(PG8_SA(0, 1), a2 + hstepA, voffA);
            PG8_WAIT_V(8); PG8_WAIT_L(0); PG8_BAR; PG8_MMA(0, 0, At, B0); PG8_MMA(0, 1, At, B1); PG8_BAR; PG8_SCHED;
            PG8_LDA(At, 1, 1); PG8_STAGE(PG8_SB(1, 0), b3, voffB); PG8_STAGE(PG8_SB(1, 1), b3 + hstepB, voffB); PG8_STAGE(PG8_SA(1, 0), a3, voffA);
            PG8_WAIT_V(8); PG8_WAIT_L(0); PG8_BAR; PG8_MMA(1, 0, At, B0); PG8_MMA(1, 1, At, B1); PG8_BAR; PG8_SCHED;
            } else {
            PG8_LDB(B0, 0, 0); PG8_SCHED; PG8_LDA(At, 0, 0); PG8_STAGE(PG8_SA(1, 1), a1 + hstepA, voffA);
            PG8_WAIT_L(8); PG8_BAR; PG8_WAIT_L(0); PG8_MMA(0, 0, At, B0); PG8_BAR; PG8_SCHED;
            PG8_LDB(B1, 0, 1); PG8_STAGE(PG8_SB(0, 0), b2, voffB);
            PG8_BAR; PG8_WAIT_L(0); PG8_MMA(0, 1, At, B1); PG8_BAR;
            PG8_LDA(At, 0, 1); PG8_STAGE(PG8_SA(0, 0), a2, voffA);
            PG8_BAR; PG8_WAIT_L(0); PG8_MMA(1, 0, At, B0); PG8_BAR; PG8_SCHED;
            PG8_STAGE(PG8_SB(0, 1), b2 + hstepB, voffB);
            PG8_WAIT_V(6); PG8_BAR; PG8_MMA(1, 1, At, B1); PG8_BAR;
            PG8_LDB(B0, 1, 0); PG8_SCHED; PG8_LDA(At, 1, 0); PG8_STAGE(PG8_SA(0, 1), a2 + hstepA, voffA);
            PG8_WAIT_L(8); PG8_BAR; PG8_WAIT_L(0); PG8_MMA(0, 0, At, B0); PG8_BAR; PG8_SCHED;
            PG8_LDB(B1, 1, 1); PG8_STAGE(PG8_SB(1, 0), b3, voffB);
            PG8_BAR; PG8_WAIT_L(0); PG8_MMA(0, 1, At, B1); PG8_BAR;
            PG8_LDA(At, 1, 1); PG8_STAGE(PG8_SA(1, 0), a3, voffA);
            PG8_BAR; PG8_WAIT_L(0); PG8_MMA(1, 0, At, B0); PG8_BAR; PG8_SCHED;
            PG8_STAGE(PG8_SB(1, 1), b3 + hstepB, voffB);
            PG8_WAIT_V(6); PG8_BAR; PG8_MMA(1, 1, At, B1); PG8_BAR;
            }
        }
        if constexpr (ALIGN_EPI) { if (wr == 0) PG8_BAR; }
        if constexpr (!Epi::AFTER_DRAIN) { E(acc, cur, wr, wc, fr, fq); S.done(cur); }
        if (!has_next) break;
#pragma unroll
        for (int a = 0; a < 2; ++a)
#pragma unroll
            for (int b = 0; b < 2; ++b)
#pragma unroll
                for (int m = 0; m < 4; ++m)
#pragma unroll
                    for (int n = 0; n < 2; ++n) acc[a][b][m][n] = (f32x4){0.f, 0.f, 0.f, 0.f};
        cur = nxt; cA = nA; cB = nB; ++ui;
        if constexpr (ALIGN_EPI) { if (wr == 1) PG8_BAR; }
    }
    PG8_WAIT_V(0);
    if constexpr (!ALIGN_EPI) { if (wr == 0) PG8_BAR; }
    PG8_BAR;
    if constexpr (Epi::AFTER_DRAIN) { E.fused(acc, cur, wr, wc, fr, fq, lds, wid, lane); S.done(cur); }
#undef PG8_SA
#undef PG8_SB
#undef PG8_STAGE
#undef PG8_LDA
#undef PG8_LDB
#undef PG8_MMA
#undef PG8_WAIT_V
#undef PG8_WAIT_L
#undef PG8_BAR
#undef PG8_SCHED
}
}
#define GAS __attribute__((address_space(1)))
#define LAS __attribute__((address_space(3)))
typedef unsigned short bf16;
typedef unsigned v4u __attribute__((ext_vector_type(4)));
typedef float f32x4 __attribute__((ext_vector_type(4)));
typedef short bf16x8 __attribute__((ext_vector_type(8)));
typedef GAS unsigned gu32;
typedef GAS unsigned long long gu64;
#define RLX_AGENT __ATOMIC_RELAXED, __HIP_MEMORY_SCOPE_AGENT
#define LDS_WAIT() asm volatile("s_waitcnt lgkmcnt(0)" ::: "memory")
#define VM_WAIT() asm volatile("s_waitcnt vmcnt(0)" ::: "memory")
__device__ __forceinline__ unsigned long long rt() { return __builtin_amdgcn_s_memrealtime(); }
__device__ __forceinline__ unsigned f2bf(float f) { unsigned u = __builtin_bit_cast(unsigned, f); return (u + 0x7fffu + ((u >> 16) & 1u)) >> 16; }
__device__ __forceinline__ unsigned pk2(float lo, float hi) { return f2bf(lo) | (f2bf(hi) << 16); }

#define XB_TMO      128
#define XB_XCNT(j)  (256  + 64 * (j))
#define XB_XSUB(j)  (1280 + 64 * (j))
#define XB_XGEN(j)  (2304 + 64 * (j))
#define XB_TOP      3328
#define XB_TOPGEN   3392
#define XCD_BAR_WORDS 3456
#define XB_SPIN_CAP (1u << 18)

__device__ __forceinline__ unsigned xb_ld(unsigned* p)              { return __hip_atomic_load(p, __ATOMIC_RELAXED, __HIP_MEMORY_SCOPE_AGENT); }
__device__ __forceinline__ unsigned xb_add(unsigned* p, unsigned v) { return __hip_atomic_fetch_add(p, v, __ATOMIC_RELAXED, __HIP_MEMORY_SCOPE_AGENT); }
__device__ __forceinline__ unsigned xb_xcc_id() { return (unsigned)__builtin_amdgcn_s_getreg((3 << 11) | 20) & 0xFu; }
#define XB_SPIN(cond, bar) do { unsigned _sp = 0; while (cond) { __builtin_amdgcn_s_sleep(1); \
    if ((++_sp & 255u) == 0u) { if (xb_ld(&(bar)[XB_TMO])) break; if (_sp > XB_SPIN_CAP) { atomicAdd(&(bar)[XB_TMO], 1u); break; } } } } while (0)

struct XcdBarrier {
    unsigned* bar; unsigned x;
    volatile LAS unsigned* st;
};

__device__ __forceinline__ XcdBarrier xcd_barrier_post(unsigned* bar, volatile LAS unsigned* st) {
    XcdBarrier b; b.bar = bar; b.x = xb_xcc_id(); b.st = st;
    if (threadIdx.x == 0) (void)xb_add(&bar[XB_XCNT(b.x)], 1u);
    return b;
}
__device__ __forceinline__ void xcd_barrier_complete(unsigned* bar, unsigned x, unsigned& nloc, unsigned& nx) {
    const unsigned G = gridDim.x * gridDim.y * gridDim.z;
    unsigned sum, cnt, mine, sp = 0u;
    for (;;) {
        sum = 0u; cnt = 0u; mine = 0u;
#pragma unroll
        for (unsigned j = 0; j < 16; ++j) { const unsigned c = xb_ld(&bar[XB_XCNT(j)]); sum += c; cnt += (c > 0u) ? 1u : 0u; mine = (j == x) ? c : mine; }
        if (sum == G) break;
        __builtin_amdgcn_s_sleep(1);
        if ((++sp & 255u) == 0u) { if (xb_ld(&bar[XB_TMO])) break; if (sp > XB_SPIN_CAP) { atomicAdd(&bar[XB_TMO], 1u); break; } }
    }
    nloc = mine > 0u ? mine : 1u; nx = cnt > 0u ? cnt : 1u;
}

__device__ __forceinline__ void xcd_barrier(const XcdBarrier& b) {
    asm volatile("s_waitcnt vmcnt(0)" ::: "memory");
    __syncthreads();
    if (threadIdx.x == 0) {
        unsigned* bar = b.bar;
        __builtin_amdgcn_s_waitcnt(0);
        unsigned nloc = b.st[0], nx = b.st[1];
        if (nloc == 0u) { xcd_barrier_complete(bar, b.x, nloc, nx); b.st[0] = nloc; b.st[1] = nx; }
        const unsigned old = xb_add(&bar[XB_XSUB(b.x)], 1u);
        const unsigned gen = old / nloc;
        if (old + 1u == (gen + 1u) * nloc) {
            __builtin_amdgcn_fence(__ATOMIC_RELEASE, "agent");
            asm volatile("s_waitcnt vmcnt(0)" ::: "memory");
            const unsigned og = xb_add(&bar[XB_TOP], 1u);
            const unsigned tg = og / nx;
            if (og + 1u == (tg + 1u) * nx) xb_add(&bar[XB_TOPGEN], 1u);
            else XB_SPIN(xb_ld(&bar[XB_TOPGEN]) == tg, bar);
            __builtin_amdgcn_fence(__ATOMIC_ACQUIRE, "agent");
            xb_add(&bar[XB_XGEN(b.x)], 1u);
            asm volatile("s_waitcnt vmcnt(0)" ::: "memory");
        } else {
            XB_SPIN(xb_ld(&bar[XB_XGEN(b.x)]) == gen, bar);
            __builtin_amdgcn_fence(__ATOMIC_ACQUIRE, "agent");
            asm volatile("s_waitcnt vmcnt(0)" ::: "memory");
        }
    }
    __syncthreads();
}

constexpr int NWAVES = 8;
constexpr int BATCH = 2, SEQ = 8192, DM = 1024, MTOK = BATCH * SEQ, NMEM = 256, FFH = 2816, MIXW = 1536, XW = 512;
constexpr int CONV_N = 3584, NSA_N = 3328, NSA_SRC = 3120, NCMP = 511;
constexpr size_t MiB = 1u << 20;
constexpr size_t WS_CTL = 0, CTL_ZERO_BYTES = 1 * MiB;
constexpr size_t WS_STATS = 1 * MiB;
constexpr size_t WS_TAB = 2 * MiB;
constexpr size_t WS_MEMN = 3 * MiB;
constexpr size_t WS_KVM = 5 * MiB;
constexpr size_t WS_CMP = 9 * MiB;
constexpr size_t WS_GATES = 11 * MiB;
constexpr size_t WS_WCONV = 14 * MiB;
constexpr size_t WS_WNSA = 21 * MiB;
constexpr size_t WS_WOUT = 28 * MiB;
constexpr size_t WS_WFFI = 34 * MiB;
constexpr size_t WS_WFFO = 56 * MiB;
constexpr size_t WS_WMKV = 67 * MiB;
constexpr size_t WS_WC1 = 71 * MiB;
constexpr size_t WS_WC2 = 72 * MiB;
constexpr size_t WS_XN = 73 * MiB;
constexpr size_t WS_MIX = 105 * MiB;
constexpr size_t WS_UNION = 153 * MiB;
constexpr size_t WS_UB = WS_UNION, WS_V = WS_UNION + 32 * MiB, WS_XQ0 = WS_UNION + 64 * MiB;
constexpr size_t WS_HID = WS_UNION;
constexpr size_t WS_Q = WS_UNION, WS_KV = WS_UNION + 32 * MiB, WS_XQ1 = WS_UNION + 82 * MiB;
constexpr size_t WS_END = 253 * MiB;
static_assert(WS_XQ1 + 16 * MiB <= WS_END && WS_HID + 88 * MiB <= WS_END, "ws map");
constexpr int CW_BAR = 4096;

constexpr int RING_OFF = 0, RING_BYTES = 155648;
constexpr int LDSCTL_OFF = RING_BYTES, MISC_OFF = LDSCTL_OFF + 320;
constexpr int LDS_BYTES = 159744;

struct Frame {
    LAS unsigned char* lds;
    volatile LAS unsigned* MISC;
    gu32* ctl;
    int tid, lane, wave, vcu, G;
};
__device__ __forceinline__ float wave_sum(float v) {
#pragma unroll
    for (int o = 1; o < 64; o <<= 1) v += __shfl_xor(v, o);
    return v;
}
struct Args { const float* in[20]; float* out; unsigned char* ws; int ph_lo, ph_hi, li, pad; };

__device__ __forceinline__ Frame mk_frame(unsigned char* ldsraw, unsigned char* ws) {
    Frame F; F.lds = (LAS unsigned char*)ldsraw; F.MISC = (volatile LAS unsigned*)(F.lds + MISC_OFF);
    int t = threadIdx.x; asm volatile("" : "+v"(t)); F.tid = t; F.lane = t & 63; F.wave = __builtin_amdgcn_readfirstlane(t >> 6);
    F.G = gridDim.x; { const int bx = blockIdx.x; F.vcu = (F.G % 8 == 0) ? (bx % 8) * (F.G / 8) + bx / 8 : bx; }
    F.ctl = (gu32*)(ws + WS_CTL); return F;
}

namespace att {
typedef float f32x16 __attribute__((ext_vector_type(16)));
typedef short s16x4 __attribute__((ext_vector_type(4)));
typedef short v4i16_t __attribute__((ext_vector_type(4)));
typedef __attribute__((address_space(3))) const unsigned char* lcp;
constexpr float LOG2E = 1.4426950408889634f;
constexpr float NEG_BIG = -1.0e30f;
__device__ __forceinline__ unsigned cvtpk(float lo, float hi) { typedef float f2 __attribute__((ext_vector_type(2))); typedef __bf16 b2 __attribute__((ext_vector_type(2))); f2 v = {lo, hi}; b2 b = __builtin_convertvector(v, b2); return __builtin_bit_cast(unsigned, b); }
__device__ __forceinline__ float xhalf_max(float m) { auto rr = __builtin_amdgcn_permlane32_swap(__float_as_uint(m), __float_as_uint(m), false, false); return fmaxf(__uint_as_float(rr[0]), __uint_as_float(rr[1])); }
__device__ __forceinline__ float xhalf_sum(float m) { auto rr = __builtin_amdgcn_permlane32_swap(__float_as_uint(m), __float_as_uint(m), false, false); return __uint_as_float(rr[0]) + __uint_as_float(rr[1]); }
__device__ __forceinline__ s16x4 vtr(lcp p) { return __builtin_bit_cast(s16x4, __builtin_amdgcn_ds_read_tr16_b64_v4i16((__attribute__((address_space(3))) v4i16_t*)p)); }

template <int NB> __device__ __forceinline__ void dma_tile(const void* gsrc, LAS unsigned char* slot, int wave, int lane) {
#pragma unroll
    for (int i = 0; i < NB / 8192; ++i)
        __builtin_amdgcn_global_load_lds((const unsigned*)((const unsigned char*)gsrc + (i * 8 + wave) * 1024 + lane * 16), (LAS unsigned*)(slot + (i * 8 + wave) * 1024), 16, 0, 0);
}
template <int D> __device__ __forceinline__ void qk_tile(f32x16& p0, f32x16& p1, lcp Kslot, const bf16x8 (&q)[D / 16], int r, int hh) {
    lcp kb = Kslot + hh * 1024 + r * 16;
    p0 = (f32x16){0.f}; p1 = (f32x16){0.f};
#pragma unroll
    for (int ks = 0; ks < D / 16; ++ks) {
        const bf16x8 a0 = *(const LAS bf16x8*)(kb + ks * 2048), a1 = *(const LAS bf16x8*)(kb + ks * 2048 + 512);
        p0 = __builtin_amdgcn_mfma_f32_32x32x16_bf16(a0, q[ks], p0, 0, 0, 0);
        p1 = __builtin_amdgcn_mfma_f32_32x32x16_bf16(a1, q[ks], p1, 0, 0, 0);
    }
}
template <int D> __device__ __forceinline__ void pv_tile(f32x16 (&o)[D / 32], lcp Vslot, const f32x16& p0, const f32x16& p1, int lane) {
    const int hh = lane >> 5;
    lcp vb = Vslot + ((lane >> 4) & 1) * 32 + (lane & 3) * 8 + (4 * hh + ((lane & 15) >> 2)) * 64;
    v4u pw[4];
    pw[0] = (v4u){cvtpk(p0[0], p0[1]), cvtpk(p0[2], p0[3]), cvtpk(p0[4], p0[5]), cvtpk(p0[6], p0[7])};
    pw[1] = (v4u){cvtpk(p0[8], p0[9]), cvtpk(p0[10], p0[11]), cvtpk(p0[12], p0[13]), cvtpk(p0[14], p0[15])};
    pw[2] = (v4u){cvtpk(p1[0], p1[1]), cvtpk(p1[2], p1[3]), cvtpk(p1[4], p1[5]), cvtpk(p1[6], p1[7])};
    pw[3] = (v4u){cvtpk(p1[8], p1[9]), cvtpk(p1[10], p1[11]), cvtpk(p1[12], p1[13]), cvtpk(p1[14], p1[15])};
#pragma unroll
    for (int d0 = 0; d0 < D / 32; ++d0)
#pragma unroll
        for (int s = 0; s < 4; ++s) {
            const s16x4 lo = vtr(vb + d0 * 4096 + s * 1024), hi = vtr(vb + d0 * 4096 + s * 1024 + 512);
            const bf16x8 vf = (bf16x8){lo[0], lo[1], lo[2], lo[3], hi[0], hi[1], hi[2], hi[3]};
            o[d0] = __builtin_amdgcn_mfma_f32_32x32x16_bf16(vf, __builtin_bit_cast(bf16x8, pw[s]), o[d0], 0, 0, 0);
        }
}
template <int ND> __device__ __forceinline__ void softmax_step(f32x16& p0, f32x16& p1, float& m, float& l, f32x16 (&o)[ND]) {
    float mx = fmaxf(p0[0], p1[0]);
#pragma unroll
    for (int i = 1; i < 16; ++i) mx = fmaxf(mx, fmaxf(p0[i], p1[i]));
    mx = xhalf_max(mx);
    const float mn = fmaxf(m, mx);
    const float alpha = __builtin_amdgcn_exp2f(m - mn);
    float s = 0.f;
#pragma unroll
    for (int i = 0; i < 16; ++i) { p0[i] = p0[i] > -1.0e29f ? __builtin_amdgcn_exp2f(p0[i] - mn) : 0.f; p1[i] = p1[i] > -1.0e29f ? __builtin_amdgcn_exp2f(p1[i] - mn) : 0.f; s += p0[i] + p1[i]; }
    l = l * alpha + s; m = mn;
#pragma unroll
    for (int d = 0; d < ND; ++d) o[d] = o[d] * alpha;
}
}

constexpr size_t WS_MKI = 5 * MiB;
constexpr size_t WS_MVI = 6 * MiB;
constexpr size_t WS_KCI = 9 * MiB;
constexpr size_t WS_VCI = 10 * MiB;
constexpr size_t TAB_BIAS2 = 0;
constexpr size_t TAB_POSB = 16384;
__device__ const unsigned char T5TAB[128] = {0, 1, 2, 3, 4, 5, 6, 7, 8, 9, 10, 11, 12, 13, 14, 15, 16, 16, 16, 17, 17, 18, 18, 18, 19, 19, 19, 20, 20, 20, 20, 21, 21, 21, 21, 22, 22, 22, 22, 22, 23, 23, 23, 23, 23, 23, 24, 24, 24, 24, 24, 24, 25, 25, 25, 25, 25, 25, 25, 26, 26, 26, 26, 26, 26, 26, 26, 27, 27, 27, 27, 27, 27, 27, 27, 27, 27, 28, 28, 28, 28, 28, 28, 28, 28, 28, 28, 29, 29, 29, 29, 29, 29, 29, 29, 29, 29, 29, 29, 30, 30, 30, 30, 30, 30, 30, 30, 30, 30, 30, 30, 30, 30, 31, 31, 31, 31, 31, 31, 31, 31, 31, 31, 31, 31, 31, 31, 31};

__device__ __forceinline__ void p0_tables(Frame& F, const Args& a) {
    const int gw = F.vcu * NWAVES + F.wave;
    float* tab = (float*)(a.ws + WS_TAB);
    if (gw < 32) {
        const int h = gw >> 1, d = (gw & 1) * 64 + F.lane;
        tab[TAB_BIAS2 / 4 + h * 128 + d] = a.in[15][(int)T5TAB[d] * 16 + h] * att::LOG2E;
    } else if (gw < 64) {
        const int it = gw - 32, kq = it >> 2, kv = (it >> 1) & 1, n = (it & 1) * 64 + F.lane;
        const float* pos = a.in[kv ? 12 : 9]; const float* w1 = a.in[kv ? 13 : 10];
        float s = 0.f;
        for (int k = kq * 256; k < kq * 256 + 256; ++k) s += pos[k] * w1[(size_t)k * 128 + n];
        tab[TAB_POSB / 4 + (kq * 2 + kv) * 128 + n] = s;
    }
}

__device__ __forceinline__ void conv_phase(Frame& F, const Args& a) {
    const bf16* UB = (const bf16*)(a.ws + WS_UB); const bf16* V = (const bf16*)(a.ws + WS_V); bf16* MIX = (bf16*)(a.ws + WS_MIX); const float* cw = a.in[7];
    for (int blk = F.vcu; blk < MTOK / 64; blk += F.G) {
        for (int idx = F.tid; idx < 64 * 128; idx += NWAVES * 64) {
            const int t = blk * 64 + (idx >> 7), c = (idx & 127) * 8, tl = t & (SEQ - 1);
            const bf16x8 ub = *(const bf16x8*)(UB + (size_t)t * DM + c), v2 = *(const bf16x8*)(V + (size_t)t * DM + c);
            bf16x8 v1 = (bf16x8){0, 0, 0, 0, 0, 0, 0, 0}, v0 = v1;
            if (tl >= 1) v1 = *(const bf16x8*)(V + (size_t)(t - 1) * DM + c);
            if (tl >= 2) v0 = *(const bf16x8*)(V + (size_t)(t - 2) * DM + c);
            const f32x4 wa0 = *(const f32x4*)(cw + c), wa1 = *(const f32x4*)(cw + c + 4), wb0 = *(const f32x4*)(cw + DM + c), wb1 = *(const f32x4*)(cw + DM + c + 4), wc0 = *(const f32x4*)(cw + 2 * DM + c), wc1 = *(const f32x4*)(cw + 2 * DM + c + 4);
            float o[8];
#pragma unroll
            for (int e = 0; e < 8; ++e) { const float w0 = e < 4 ? wa0[e & 3] : wa1[e & 3], w1 = e < 4 ? wb0[e & 3] : wb1[e & 3], w2 = e < 4 ? wc0[e & 3] : wc1[e & 3];
                const float f0 = __uint_as_float((unsigned)(unsigned short)v0[e] << 16), f1 = __uint_as_float((unsigned)(unsigned short)v1[e] << 16), f2 = __uint_as_float((unsigned)(unsigned short)v2[e] << 16), fb = __uint_as_float((unsigned)(unsigned short)ub[e] << 16);
                o[e] = fb * (w0 * f0 + w1 * f1 + w2 * f2); }
            v4u w; w.x = att::cvtpk(o[0], o[1]); w.y = att::cvtpk(o[2], o[3]); w.z = att::cvtpk(o[4], o[5]); w.w = att::cvtpk(o[6], o[7]);
            *(v4u*)(MIX + (size_t)t * MIXW + c) = w;
        }
    }
}

__device__ __forceinline__ void memattn_phase(Frame& F, const Args& a, int layer, const bf16* XQ) {
    using namespace att;
    bf16* MIX = (bf16*)(a.ws + WS_MIX);
    const int lane = F.lane, r = lane & 31, hh = lane >> 5;
    LAS unsigned char* Ks = F.lds + RING_OFF; LAS unsigned char* Vs = F.lds + RING_OFF + 32768;
    for (int u = F.vcu; u < 256; u += F.G) {
        const int b = u >> 7, head = (u >> 5) & 3, qb = u & 31;
        const unsigned char* Kimg = a.ws + WS_MKI + (size_t)((layer * 2 + b) * 4 + head) * 65536; const unsigned char* Vimg = a.ws + WS_MVI + (size_t)((layer * 2 + b) * 4 + head) * 65536;
        const size_t row = (size_t)b * SEQ + qb * 256 + F.wave * 32 + r;
        bf16x8 q[8];
#pragma unroll
        for (int ks = 0; ks < 8; ++ks) q[ks] = *(const bf16x8*)(XQ + row * XW + head * 128 + 16 * ks + 8 * hh);
        f32x16 o[4]; o[0] = (f32x16){0.f}; o[1] = o[0]; o[2] = o[0]; o[3] = o[0];
        float m = NEG_BIG, l = 0.f;
        dma_tile<16384>(Kimg, Ks, F.wave, lane); dma_tile<16384>(Vimg, Vs, F.wave, lane);
#pragma unroll 1
        for (int t = 0; t < 4; ++t) {
            asm volatile("s_waitcnt vmcnt(0)" ::: "memory"); __syncthreads();
            if (t + 1 < 4) { dma_tile<16384>(Kimg + (t + 1) * 16384, Ks + ((t + 1) & 1) * 16384, F.wave, lane); dma_tile<16384>(Vimg + (t + 1) * 16384, Vs + ((t + 1) & 1) * 16384, F.wave, lane); }
            f32x16 p0, p1;
            qk_tile<128>(p0, p1, (lcp)(Ks + (t & 1) * 16384), q, r, hh);
            const float sc = 0.08838834764831845f * LOG2E;
#pragma unroll
            for (int i = 0; i < 16; ++i) { p0[i] *= sc; p1[i] *= sc; }
            softmax_step<4>(p0, p1, m, l, o);
            pv_tile<128>(o, (lcp)(Vs + (t & 1) * 16384), p0, p1, lane);
        }
        l = xhalf_sum(l); const float inv = 1.f / l;
        bf16* orow = MIX + row * MIXW + 1024 + head * 128 + 4 * hh;
#pragma unroll
        for (int d0 = 0; d0 < 4; ++d0)
#pragma unroll
            for (int i4 = 0; i4 < 4; ++i4) { typedef unsigned u32x2 __attribute__((ext_vector_type(2)));
                u32x2 w; w.x = cvtpk(o[d0][4 * i4] * inv, o[d0][4 * i4 + 1] * inv); w.y = cvtpk(o[d0][4 * i4 + 2] * inv, o[d0][4 * i4 + 3] * inv);
                *(u32x2*)(orow + 32 * d0 + 8 * i4) = w; }
        __syncthreads();
    }
}

__device__ __forceinline__ void cmpmlp_phase(Frame& F, const Args& a) {
    using namespace att;
    const int lane = F.lane, r = lane & 31, hh = lane >> 5, rh = F.wave >> 2, ct = F.wave & 3;
    const float* tab = (const float*)(a.ws + WS_TAB);
    LAS unsigned short* HM = (LAS unsigned short*)(F.lds + RING_OFF);
    for (int u = F.vcu; u < 128; u += F.G) {
        const int kv = u >> 6, bg = (u >> 3) & 7, rb = u & 7;
        const bf16* raw = (const bf16*)(a.ws + WS_KV) + (size_t)(kv * 8 + bg) * 8192 * 64;
        const bf16* W1T = (const bf16*)(a.ws + WS_WC1) + (size_t)kv * 128 * 2048;
        const bf16* ap = raw + (size_t)(rb * 64 + rh * 32 + r) * 1024 + 8 * hh;
        const bf16* bp = W1T + (size_t)(ct * 32 + r) * 2048 + 8 * hh;
        f32x16 acc = (f32x16){0.f};
#pragma unroll 8
        for (int ks = 0; ks < 128; ++ks) acc = __builtin_amdgcn_mfma_f32_32x32x16_bf16(*(const bf16x8*)(ap + 16 * ks), *(const bf16x8*)(bp + 16 * ks), acc, 0, 0, 0);
        const int n = ct * 32 + r; float pb = 0.f;
#pragma unroll
        for (int kq = 0; kq < 8; ++kq) pb += tab[TAB_POSB / 4 + (kq * 2 + kv) * 128 + n];
#pragma unroll
        for (int i = 0; i < 16; ++i) { const float x = acc[i] + pb; const float hm = x * __builtin_amdgcn_rcpf(1.f + __builtin_amdgcn_exp2f(-LOG2E * x));
            const int c = rh * 32 + (i & 3) + 8 * (i >> 2) + 4 * hh; HM[c * 136 + n] = (unsigned short)(cvtpk(hm, 0.f) & 0xffffu); }
        __syncthreads();
        if (F.wave < 4) {
            const int rh2 = F.wave >> 1, dt = F.wave & 1;
            const bf16* W2T = (const bf16*)(a.ws + WS_WC2) + (size_t)kv * 64 * 128;
            f32x16 o = (f32x16){0.f};
#pragma unroll
            for (int ks = 0; ks < 8; ++ks) { const bf16x8 af = *(const LAS bf16x8*)(HM + (rh2 * 32 + r) * 136 + 16 * ks + 8 * hh); const bf16x8 bfr = *(const bf16x8*)(W2T + (size_t)(dt * 32 + r) * 128 + 16 * ks + 8 * hh);
                o = __builtin_amdgcn_mfma_f32_32x32x16_bf16(af, bfr, o, 0, 0, 0); }
            const int d = dt * 32 + r;
            bf16* img = (bf16*)(a.ws + (kv ? WS_VCI : WS_KCI)) + (size_t)bg * 512 * 64;
#pragma unroll
            for (int i = 0; i < 16; ++i) { const int c = rb * 64 + rh2 * 32 + (i & 3) + 8 * (i >> 2) + 4 * hh; const float v = c < NCMP ? o[i] : 0.f;
                const size_t off = kv ? ((size_t)(c >> 6) * 4096 + (d >> 5) * 2048 + (c & 63) * 32 + (d & 31)) : ((size_t)(c >> 6) * 4096 + (d >> 3) * 512 + (c & 63) * 8 + (d & 7));
                img[off] = (bf16)(cvtpk(v, 0.f) & 0xffffu); }
        }
        __syncthreads();
    }
}

constexpr int NSA_KS = 0, NSA_VS = 16384, NSA_IMP = 32768, NSA_SELM = NSA_IMP + 64 * 129 * 4, NSA_BT = NSA_SELM + 1024, NSA_OT = NSA_BT + 2048, NSA_END = NSA_OT + 65536;
static_assert(NSA_END <= RING_BYTES && NSA_SELM % 16 == 0, "nsa lds map");

constexpr float M_INIT = -1.0e4f;
template <int MODE>
__device__ __forceinline__ void nsa_tiles(LAS unsigned char* lds, const unsigned char* Kimg, const unsigned char* Vimg, int jt0, int jt1, const bf16x8 (&q)[4], int wave, int lane, int tq, int cur, int hd, int qi,
                                          float& m, float& l, att::f32x16 (&o)[2], float linv2) {
    using namespace att;
    const int r = lane & 31, hh = lane >> 5, tql = tq - r;
    LAS unsigned char* Ks = lds + NSA_KS; LAS unsigned char* Vs = lds + NSA_VS;
    const LAS float* BT = (const LAS float*)(lds + NSA_BT) + hd * 128;
    LAS unsigned* IMP = (LAS unsigned*)(lds + NSA_IMP);
    const LAS unsigned* SELM = (const LAS unsigned*)(lds + NSA_SELM);
    const float C2 = 0.125f * LOG2E;
    const float b31 = BT[127];
    dma_tile<8192>(Kimg + (size_t)jt0 * 8192, Ks, wave, lane);
    if (MODE != 0) dma_tile<8192>(Vimg + (size_t)jt0 * 8192, Vs, wave, lane);
#pragma unroll 1
    for (int jt = jt0; jt <= jt1; ++jt) {
        const int sl = (jt - jt0) & 1;
        asm volatile("s_waitcnt vmcnt(0)" ::: "memory"); __syncthreads();
        if (jt < jt1) { dma_tile<8192>(Kimg + (size_t)(jt + 1) * 8192, Ks + (sl ^ 1) * 8192, wave, lane); if (MODE != 0) dma_tile<8192>(Vimg + (size_t)(jt + 1) * 8192, Vs + (sl ^ 1) * 8192, wave, lane); }
        bool far; bool selb = true;
        if (MODE <= 1) far = (tql - 16 * (64 * jt + 63) - 31) >= 113;
        else if (MODE == 2) { far = jt <= cur - 3; selb = (SELM[qi * 4 + (jt >> 5)] >> (jt & 31)) & 1u; if (!__any(selb)) continue; }
        else far = (tql - (64 * jt + 63)) >= 113 && (tql + 31 - 64 * jt) < 512;
        f32x16 p0, p1;
        qk_tile<64>(p0, p1, (lcp)(Ks + sl * 8192), q, r, hh);
        if (far) {
            const float badd = selb ? b31 : NEG_BIG;
            if (MODE != 1) {
                float mx = fmaxf(p0[0], p1[0]);
#pragma unroll
                for (int i = 1; i < 16; ++i) mx = fmaxf(mx, fmaxf(p0[i], p1[i]));
                mx = xhalf_max(mx);
                const float mn = fmaxf(m, mx * C2 + badd);
                if (__any(mn > m)) { const float alpha = __builtin_amdgcn_exp2f(m - mn); l *= alpha; m = mn;
                    if (MODE != 0) { o[0] = o[0] * alpha; o[1] = o[1] * alpha; } }
            }
            const float cc = MODE == 1 ? (b31 - m + linv2) : (badd - m);
            float s = 0.f;
#pragma unroll
            for (int i = 0; i < 16; ++i) { p0[i] = __builtin_amdgcn_exp2f(p0[i] * C2 + cc); p1[i] = __builtin_amdgcn_exp2f(p1[i] * C2 + cc); s += p0[i] + p1[i]; }
            if (MODE != 1) l += s;
        } else {
            if (MODE <= 1) {
                const int db = tq - 31 - 16 * (64 * jt + 4 * hh);
#pragma unroll
                for (int i = 0; i < 16; ++i) { const int ko = (i & 3) + 8 * (i >> 2); const int d0 = db - 16 * ko, d1 = d0 - 512;
                    const float b0 = BT[d0 < 0 ? 0 : (d0 > 127 ? 127 : d0)], b1 = BT[d1 < 0 ? 0 : (d1 > 127 ? 127 : d1)];
                    const float f0 = p0[i] * C2 + b0, f1 = p1[i] * C2 + b1;
                    p0[i] = d0 >= 0 ? f0 : NEG_BIG; p1[i] = d1 >= 0 ? f1 : NEG_BIG;
                    if ((i & 3) == 3) asm volatile("" ::: "memory"); }
            } else {
                const int db = tq - (64 * jt + 4 * hh);
#pragma unroll
                for (int i = 0; i < 16; ++i) { const int ko = (i & 3) + 8 * (i >> 2); const int d0 = db - ko, d1 = d0 - 32;
                    const bool v0 = selb && d0 >= 0 && (MODE != 3 || d0 < 512), v1 = selb && d1 >= 0 && (MODE != 3 || d1 < 512);
                    const float b0 = BT[d0 < 0 ? 0 : (d0 > 127 ? 127 : d0)], b1 = BT[d1 < 0 ? 0 : (d1 > 127 ? 127 : d1)];
                    const float f0 = p0[i] * C2 + b0, f1 = p1[i] * C2 + b1;
                    p0[i] = v0 ? f0 : NEG_BIG; p1[i] = v1 ? f1 : NEG_BIG;
                    if ((i & 3) == 3) asm volatile("" ::: "memory"); }
            }
            if (MODE != 1) {
                float mx = fmaxf(p0[0], p1[0]);
#pragma unroll
                for (int i = 1; i < 16; ++i) mx = fmaxf(mx, fmaxf(p0[i], p1[i]));
                mx = xhalf_max(mx);
                const float mn = fmaxf(m, mx);
                if (__any(mn > m)) { const float alpha = __builtin_amdgcn_exp2f(m - mn); l *= alpha; m = mn;
                    if (MODE != 0) { o[0] = o[0] * alpha; o[1] = o[1] * alpha; } }
            }
            const float cc = MODE == 1 ? (linv2 - m) : -m;
            float s = 0.f;
#pragma unroll
            for (int i = 0; i < 16; ++i) { p0[i] = __builtin_amdgcn_exp2f(p0[i] + cc); p1[i] = __builtin_amdgcn_exp2f(p1[i] + cc); s += p0[i] + p1[i]; }
            if (MODE != 1) l += s;
        }
        if (MODE == 1) {
#pragma unroll
            for (int i4 = 0; i4 < 4; ++i4) {
#pragma unroll
                for (int pp = 0; pp < 2; ++pp) {
                    const float x0 = pp ? p1[4 * i4] : p0[4 * i4], x1 = pp ? p1[4 * i4 + 1] : p0[4 * i4 + 1], x2 = pp ? p1[4 * i4 + 2] : p0[4 * i4 + 2], x3 = pp ? p1[4 * i4 + 3] : p0[4 * i4 + 3];
                    const int js = 16 * jt + 8 * pp + 2 * i4 + hh;
                    const float a = (x0 + x1) + (x2 + 0.5f * x3), bq = 0.5f * x3;
                    if (a > 0.f) { __hip_atomic_fetch_add(IMP + qi * 129 + js, (unsigned)(a * 16777216.f + 0.5f), __ATOMIC_RELAXED, __HIP_MEMORY_SCOPE_WORKGROUP);
                        if (js + 1 < 128 && bq > 0.f) __hip_atomic_fetch_add(IMP + qi * 129 + js + 1, (unsigned)(bq * 16777216.f + 0.5f), __ATOMIC_RELAXED, __HIP_MEMORY_SCOPE_WORKGROUP); }
                }
            }
        }
        if (MODE != 0) pv_tile<64>(o, (lcp)(Vs + sl * 8192), p0, p1, lane);
    }
    __syncthreads();
}

__device__ __forceinline__ unsigned wave_max_u32(unsigned v) {
#pragma unroll
    for (int o = 1; o < 64; o <<= 1) { const unsigned t = (unsigned)__shfl_xor((int)v, o); v = t > v ? t : v; }
    return v;
}

__device__ __forceinline__ void nsa_phase(Frame& F, const Args& a) {
    using namespace att;
    const int lane = F.lane, r = lane & 31, hh = lane >> 5, wave = F.wave, hd = wave & 3, half = wave >> 2;
    LAS unsigned* IMP = (LAS unsigned*)(F.lds + RING_OFF + NSA_IMP); LAS unsigned* SELM = (LAS unsigned*)(F.lds + RING_OFF + NSA_SELM); LAS float* BTw = (LAS float*)(F.lds + RING_OFF + NSA_BT);
    const float* tab = (const float*)(a.ws + WS_TAB);
    const bf16* Q = (const bf16*)(a.ws + WS_Q); const float* GATES = (const float*)(a.ws + WS_GATES); bf16* MIX = (bf16*)(a.ws + WS_MIX);
#pragma unroll 1
    for (int it = 0; it * F.G + F.vcu < 1024; ++it) {
        int bg, cur;
        if (F.G == 256) { const int s = F.vcu & 31; bg = F.vcu >> 5; cur = it == 0 ? s : (it == 1 ? 63 - s : (it == 2 ? 64 + s : 127 - s)); }
        else { const int u = it * F.G + F.vcu; bg = u >> 7; cur = u & 127; }
        const int b = bg >> 2, g = bg & 3, h = 4 * g + hd, qi = 32 * half + r, tq = 64 * cur + qi;
        const size_t rowq = (size_t)b * SEQ + tq;
        bf16x8 q[4];
#pragma unroll
        for (int ks = 0; ks < 4; ++ks) q[ks] = *(const bf16x8*)(Q + rowq * 1024 + h * 64 + 16 * ks + 8 * hh);
        const float gc = GATES[rowq * 48 + h], gs = GATES[rowq * 48 + 16 + h], gw = GATES[rowq * 48 + 32 + h];
        for (int i = F.tid; i < 64 * 129; i += NWAVES * 64) IMP[i] = 0u;
        if (F.tid < 256) SELM[F.tid] = 0u;
        BTw[F.tid] = tab[TAB_BIAS2 / 4 + (4 * g) * 128 + F.tid];
        __syncthreads();
        const unsigned char* slab = a.ws + WS_KV + (size_t)bg * 8192 * 64 * 2;
        constexpr size_t SLAB = (size_t)8 * 8192 * 64 * 2;
        f32x16 ot[2];
        LAS float* OT = (LAS float*)(F.lds + RING_OFF + NSA_OT) + wave * 2048 + lane;
        {
            const unsigned char* Kc = a.ws + WS_KCI + (size_t)bg * 65536; const unsigned char* Vc = a.ws + WS_VCI + (size_t)bg * 65536;
            const int nct = (4 * cur + 2) / 64;
            float m = M_INIT, l = 0.f; f32x16 oc[2]; oc[0] = (f32x16){0.f}; oc[1] = oc[0];
            nsa_tiles<0>(F.lds + RING_OFF, Kc, Vc, 0, nct, q, wave, lane, tq, cur, hd, qi, m, l, oc, 0.f);
            l = xhalf_sum(l); const float linv2 = -__builtin_amdgcn_logf(l);
            nsa_tiles<1>(F.lds + RING_OFF, Kc, Vc, 0, nct, q, wave, lane, tq, cur, hd, qi, m, l, oc, l > 0.f ? linv2 : NEG_BIG);
#pragma unroll
            for (int i = 0; i < 16; ++i) { OT[i * 64] = oc[0][i] * gc; OT[(16 + i) * 64] = oc[1][i] * gc; }
        }
#pragma unroll 1
        for (int bt = 0; bt < 2; ++bt) {
            const int qs = wave * 8 + bt * 4 + (lane >> 4), l16 = lane & 15;
            unsigned sm = 0u;
            if (cur < 16) {
#pragma unroll
                for (int sI = 0; sI < 8; ++sI) if (l16 + 16 * sI <= cur) sm |= 1u << sI;
            } else {
                unsigned key[8];
#pragma unroll
                for (int sI = 0; sI < 8; ++sI) { const int j = l16 + 16 * sI; const unsigned im = IMP[qs * 129 + j];
                    const bool forced = (j == 0) || (j == cur) || (j == cur - 1);
                    key[sI] = (forced || j > cur) ? 0u : ((((im >> 4) + 1u) << 7) | (unsigned)(127 - j));
                    if (forced) sm |= 1u << sI; }
#pragma unroll 1
                for (int k = 0; k < 13; ++k) {
                    unsigned lm = key[0];
#pragma unroll
                    for (int sI = 1; sI < 8; ++sI) lm = key[sI] > lm ? key[sI] : lm;
                    unsigned rm = lm, t;
                    t = (unsigned)__builtin_amdgcn_update_dpp(0, (int)rm, 0x121, 0xf, 0xf, false); rm = t > rm ? t : rm;
                    t = (unsigned)__builtin_amdgcn_update_dpp(0, (int)rm, 0x122, 0xf, 0xf, false); rm = t > rm ? t : rm;
                    t = (unsigned)__builtin_amdgcn_update_dpp(0, (int)rm, 0x124, 0xf, 0xf, false); rm = t > rm ? t : rm;
                    t = (unsigned)__builtin_amdgcn_update_dpp(0, (int)rm, 0x128, 0xf, 0xf, false); rm = t > rm ? t : rm;
#pragma unroll
                    for (int sI = 0; sI < 8; ++sI) { const bool hit = (key[sI] == rm) && (rm != 0u); sm |= hit ? (1u << sI) : 0u; key[sI] = hit ? 0u : key[sI]; }
                }
            }
#pragma unroll
            for (int w = 0; w < 4; ++w) { const unsigned bits = (((sm >> (2 * w)) & 1u) << l16) | (((sm >> (2 * w + 1)) & 1u) << (l16 + 16));
                if (bits) __hip_atomic_fetch_or(SELM + qs * 4 + w, bits, __ATOMIC_RELAXED, __HIP_MEMORY_SCOPE_WORKGROUP); }
        }
        __syncthreads();
        {
            float m = M_INIT, l = 0.f; f32x16 os[2]; os[0] = (f32x16){0.f}; os[1] = os[0];
            nsa_tiles<2>(F.lds + RING_OFF, slab + 2 * SLAB, slab + 3 * SLAB, 0, cur, q, wave, lane, tq, cur, hd, qi, m, l, os, 0.f);
            l = xhalf_sum(l); const float sc = gs / l;
#pragma unroll
            for (int i = 0; i < 16; ++i) { OT[i * 64] += os[0][i] * sc; OT[(16 + i) * 64] += os[1][i] * sc; }
        }
        {
            float m = M_INIT, l = 0.f; f32x16 ow[2]; ow[0] = (f32x16){0.f}; ow[1] = ow[0];
            nsa_tiles<3>(F.lds + RING_OFF, slab + 4 * SLAB, slab + 5 * SLAB, cur >= 8 ? cur - 8 : 0, cur, q, wave, lane, tq, cur, hd, qi, m, l, ow, 0.f);
            l = xhalf_sum(l); const float sc = gw / l;
#pragma unroll
            for (int i = 0; i < 16; ++i) { ot[0][i] = OT[i * 64] + ow[0][i] * sc; ot[1][i] = OT[(16 + i) * 64] + ow[1][i] * sc; }
        }
        bf16* orow = MIX + rowq * MIXW + h * 64 + 4 * hh;
#pragma unroll
        for (int d0 = 0; d0 < 2; ++d0)
#pragma unroll
            for (int i4 = 0; i4 < 4; ++i4) { typedef unsigned u32x2 __attribute__((ext_vector_type(2)));
                u32x2 w; w.x = cvtpk(ot[d0][4 * i4], ot[d0][4 * i4 + 1]); w.y = cvtpk(ot[d0][4 * i4 + 2], ot[d0][4 * i4 + 3]);
                *(u32x2*)(orow + 32 * d0 + 8 * i4) = w; }
    }
}
__device__ __forceinline__ void p0_item(const float* __restrict__ W, int K, int srcN, int sc0, int nvalid, const float* __restrict__ gvec, bf16* __restrict__ WT, int n0, int k0, LAS float* scr, int lane) {
    const bool ok = (lane & 31) < nvalid;
#pragma unroll 8
    for (int i = 0; i < 32; ++i) { const int kk = 2 * i + (lane >> 5); float v = ok ? W[(size_t)(k0 + kk) * srcN + sc0 + (lane & 31)] : 0.f; if (gvec) v *= gvec[k0 + kk]; scr[kk * 33 + (lane & 31)] = v; }
    LDS_WAIT(); asm volatile("" ::: "memory");
    const int c = lane & 7;
#pragma unroll
    for (int j = 0; j < 4; ++j) { const int n = (lane >> 3) + 8 * j; const LAS float* s = scr + (8 * c) * 33 + n;
        v4u o; o.x = pk2(s[0 * 33], s[1 * 33]); o.y = pk2(s[2 * 33], s[3 * 33]); o.z = pk2(s[4 * 33], s[5 * 33]); o.w = pk2(s[6 * 33], s[7 * 33]);
        *(GAS v4u*)(WT + (size_t)(n0 + n) * K + k0 + 8 * c) = o; }
    LDS_WAIT(); asm volatile("" ::: "memory");
}
__device__ __forceinline__ int map_conv(int n) { const int pn = n >> 8, r = n & 255; if (pn < 4 || pn >= 12) return n; const int i = pn - 4; return r < 128 ? 1024 + 128 * i + r : 2048 + 128 * i + (r - 128); }
__device__ __forceinline__ int map_ffi(int n) { const int pn = n >> 8, r = n & 255; return r < 128 ? 128 * pn + r : FFH + 128 * pn + (r - 128); }
__device__ __forceinline__ void map_nsa(int n, int& sc, int& nv) { nv = 32; if (n < 2560) sc = n; else if (n < 3072) sc = 2608 + (n - 2560); else if (n < 3120) { sc = 2560 + (n - 3072); nv = (3120 - n) < 32 ? (3120 - n) : 32; } else { sc = 0; nv = 0; } }

__device__ __forceinline__ void p0_prologue(Frame& F, const Args& a) {
    LAS float* scr = (LAS float*)(F.lds + RING_OFF + F.wave * 16384);
    const int gw = F.vcu * NWAVES + F.wave, NGW = F.G * NWAVES;
    unsigned char* ws = a.ws;
    constexpr int I_CONV = 16 * (CONV_N / 32), I_NSA = 16 * (NSA_N / 32), I_OUT = 24 * 32, I_FFI = 16 * 176, I_FFO = 44 * 32, I_MKV = 16 * 32, I_C1 = 32 * 4, I_C2 = 2 * 2;
    constexpr int NITEMS = I_CONV + I_NSA + 2 * I_OUT + 2 * I_FFI + 2 * I_FFO + 2 * I_MKV + 2 * I_C1 + 2 * I_C2;
    for (int it = gw; it < NITEMS; it += NGW) {
        int r = it;
        if (r < I_CONV) { const int nb = r % (CONV_N / 32), kb = r / (CONV_N / 32); p0_item(a.in[6], 1024, CONV_N, map_conv(32 * nb), 32, a.in[2], (bf16*)(ws + WS_WCONV), 32 * nb, 64 * kb, scr, F.lane); continue; } r -= I_CONV;
        if (r < I_NSA) { const int nb = r % (NSA_N / 32), kb = r / (NSA_N / 32); int sc, nv; map_nsa(32 * nb, sc, nv); p0_item(a.in[8], 1024, NSA_SRC, sc, nv, a.in[2] + DM, (bf16*)(ws + WS_WNSA), 32 * nb, 64 * kb, scr, F.lane); continue; } r -= I_NSA;
        if (r < 2 * I_OUT) { const int l = r / I_OUT; r -= l * I_OUT; const int nb = r % 32, kb = r / 32; p0_item(a.in[17] + (size_t)l * MIXW * DM, MIXW, DM, 32 * nb, 32, nullptr, (bf16*)(ws + WS_WOUT) + (size_t)l * DM * MIXW, 32 * nb, 64 * kb, scr, F.lane); continue; } r -= 2 * I_OUT;
        if (r < 2 * I_FFI) { const int l = r / I_FFI; r -= l * I_FFI; const int nb = r % 176, kb = r / 176; p0_item(a.in[18] + (size_t)l * DM * 2 * FFH, DM, 2 * FFH, map_ffi(32 * nb), 32, a.in[4] + l * DM, (bf16*)(ws + WS_WFFI) + (size_t)l * 2 * FFH * DM, 32 * nb, 64 * kb, scr, F.lane); continue; } r -= 2 * I_FFI;
        if (r < 2 * I_FFO) { const int l = r / I_FFO; r -= l * I_FFO; const int nb = r % 32, kb = r / 32; p0_item(a.in[19] + (size_t)l * FFH * DM, FFH, DM, 32 * nb, 32, nullptr, (bf16*)(ws + WS_WFFO) + (size_t)l * DM * FFH, 32 * nb, 64 * kb, scr, F.lane); continue; } r -= 2 * I_FFO;
        if (r < 2 * I_MKV) { const int l = r / I_MKV; r -= l * I_MKV; const int nb = r % 32, kb = r / 32; p0_item(a.in[16] + (size_t)l * DM * 1024, DM, 1024, 32 * nb, 32, nullptr, (bf16*)(ws + WS_WMKV) + (size_t)l * 1024 * DM, 32 * nb, 64 * kb, scr, F.lane); continue; } r -= 2 * I_MKV;
        if (r < 2 * I_C1) { const int l = r / I_C1; r -= l * I_C1; const int nb = r % 4, kb = r / 4; p0_item(a.in[l ? 13 : 10], 2048, 128, 32 * nb, 32, nullptr, (bf16*)(ws + WS_WC1) + (size_t)l * 128 * 2048, 32 * nb, 64 * kb, scr, F.lane); continue; } r -= 2 * I_C1;
        { const int l = r / I_C2; r -= l * I_C2; const int nb = r % 2, kb = r / 2; p0_item(a.in[l ? 14 : 11], 128, 64, 32 * nb, 32, nullptr, (bf16*)(ws + WS_WC2) + (size_t)l * 64 * 128, 32 * nb, 64 * kb, scr, F.lane); }
    }
    bf16* XN = (bf16*)(ws + WS_XN); float* ST = (float*)(ws + WS_STATS);
    for (int m = gw; m < MTOK; m += NGW) {
        const GAS f32x4* xr = (const GAS f32x4*)(a.in[0] + (size_t)m * DM) + F.lane; f32x4 v[4]; float s = 0.f;
#pragma unroll
        for (int j = 0; j < 4; ++j) { v[j] = xr[64 * j]; s += (v[j].x * v[j].x + v[j].y * v[j].y) + (v[j].z * v[j].z + v[j].w * v[j].w); }
        s = wave_sum(s);
        GAS unsigned long long* o8 = (GAS unsigned long long*)(XN + (size_t)m * DM) + F.lane;
#pragma unroll
        for (int j = 0; j < 4; ++j) o8[64 * j] = (unsigned long long)pk2(v[j].x, v[j].y) | ((unsigned long long)pk2(v[j].z, v[j].w) << 32);
        if (F.lane < 16) ST[(size_t)m * 16 + F.lane] = F.lane == 0 ? s : 0.f;
    }
    bf16* MEMN = (bf16*)(ws + WS_MEMN);
    for (int r = gw; r < 2 * BATCH * NMEM; r += NGW) { const int l = r / (BATCH * NMEM), row = r % (BATCH * NMEM);
        const GAS f32x4* xr = (const GAS f32x4*)(a.in[1] + (size_t)row * DM) + F.lane; const GAS f32x4* gr = (const GAS f32x4*)(a.in[3] + (size_t)l * DM) + F.lane; f32x4 v[4]; float s = 0.f;
#pragma unroll
        for (int j = 0; j < 4; ++j) { v[j] = xr[64 * j]; s += (v[j].x * v[j].x + v[j].y * v[j].y) + (v[j].z * v[j].z + v[j].w * v[j].w); }
        const float rs = rsqrtf(wave_sum(s) * (1.f / DM) + 1e-6f);
        GAS unsigned long long* o8 = (GAS unsigned long long*)(MEMN + (size_t)r * DM) + F.lane;
#pragma unroll
        for (int j = 0; j < 4; ++j) { const f32x4 g = gr[64 * j]; o8[64 * j] = (unsigned long long)pk2(v[j].x * rs * g.x, v[j].y * rs * g.y) | ((unsigned long long)pk2(v[j].z * rs * g.z, v[j].w * rs * g.w) << 32); }
    }
}
__device__ __forceinline__ void p_final(Frame& F, const Args& a) {
    const int gw = F.vcu * NWAVES + F.wave, NGW = F.G * NWAVES; const float* ST = (const float*)(a.ws + WS_STATS);
    for (int m = gw; m < MTOK; m += NGW) {
        const float rs = pg8::row_rstd(ST, m);
        GAS f32x4* xr = (GAS f32x4*)(a.out + (size_t)m * DM) + F.lane; const GAS f32x4* gr = (const GAS f32x4*)(a.in[5]) + F.lane;
#pragma unroll
        for (int j = 0; j < 4; ++j) xr[64 * j] = xr[64 * j] * rs * gr[64 * j];
    }
}

__global__ void __launch_bounds__(NWAVES * 64, 2) mega_fwd(Args args) {
    extern __shared__ __attribute__((aligned(16))) unsigned char lds[];
    unsigned char* ws = args.ws;
#define MKF() Frame F = mk_frame(lds, ws)
    { MKF(); for (int u = F.tid; u < (LDS_BYTES - LDSCTL_OFF) / 4; u += NWAVES * 64) ((LAS unsigned*)(F.lds + LDSCTL_OFF))[u] = 0u; }
    __syncthreads();
    LAS unsigned char* const ldsb = (LAS unsigned char*)lds; const int GG = gridDim.x;
    const int lo = args.ph_lo, hi = args.ph_hi;
    XcdBarrier bar; bar.bar = (unsigned*)(ws + WS_CTL) + CW_BAR + args.li * XCD_BAR_WORDS; bar.x = 0; bar.st = nullptr;
    if (hi - lo > 1) bar = xcd_barrier_post((unsigned*)(ws + WS_CTL) + CW_BAR + args.li * XCD_BAR_WORDS, (volatile LAS unsigned*)(ldsb + MISC_OFF) + 8);
#ifndef PHMASK
#define PHMASK 0xFFFF
#endif
#define IN(k) (((PHMASK >> (k)) & 1) && lo <= (k) && (k) < hi)
#define SEAM(k) do { if (IN(k) && IN((k) + 1)) xcd_barrier(bar); } while (0)
    bf16* XN = (bf16*)(ws + WS_XN); bf16* MIX = (bf16*)(ws + WS_MIX); float* ST = (float*)(ws + WS_STATS);
    float* H = args.out;

    if (IN(0)) { MKF(); p0_tables(F, args); p0_prologue(F, args); } SEAM(0);
    if (IN(1)) {
        if (blockIdx.x >= 128) {
            pg8::Gemm g{(const bf16*)(ws + WS_MEMN), (const bf16*)(ws + WS_WMKV), 1024, 2048, DM, DM}; pg8::DiagOrder S{128, (int)blockIdx.x - 128};
            pg8::EpiMemKV E{(bf16*)(ws + WS_MKI), (bf16*)(ws + WS_MVI)};
            pg8::gemm_phase<pg8::EpiMemKV, pg8::DiagOrder, true, true>(ldsb + RING_OFF, g, S, E);
        }
        pg8::Gemm g{XN, (const bf16*)(ws + WS_WCONV), MTOK, CONV_N, DM, DM}; pg8::StaticOrder S; S.init(MTOK, CONV_N, GG, (int)blockIdx.x);
        pg8::EpiConv E{(bf16*)(ws + WS_UB), (bf16*)(ws + WS_V), (bf16*)(ws + WS_XQ0), ST};
        pg8::gemm_phase<pg8::EpiConv, pg8::StaticOrder, true, true>(ldsb + RING_OFF, g, S, E);
    } SEAM(1);
    if (IN(2)) { MKF(); conv_phase(F, args); memattn_phase(F, args, 0, (const bf16*)(ws + WS_XQ0)); }
    SEAM(2);
#define LAYER_TAIL(l, pb) \
        if (IN(pb)) { \
            pg8::Gemm g{MIX, (const bf16*)(ws + WS_WOUT) + (size_t)(l) * DM * MIXW, MTOK, DM, MIXW, MIXW}; pg8::StaticOrder S; S.init(MTOK, DM, GG, (int)blockIdx.x); \
            pg8::EpiRes E{(l) ? H : args.in[0], H, XN, ST}; \
            pg8::gemm_phase<pg8::EpiRes, pg8::StaticOrder, true, true>(ldsb + RING_OFF, g, S, E); \
        } SEAM(pb); \
        if (IN((pb) + 1)) { \
            pg8::Gemm g{XN, (const bf16*)(ws + WS_WFFI) + (size_t)(l) * 2 * FFH * DM, MTOK, 2 * FFH, DM, DM}; pg8::StaticOrder S; S.init(MTOK, 2 * FFH, GG, (int)blockIdx.x); \
            pg8::EpiSwiglu E{(bf16*)(ws + WS_HID), ST}; \
            pg8::gemm_phase<pg8::EpiSwiglu, pg8::StaticOrder, true, true>(ldsb + RING_OFF, g, S, E); \
        } SEAM((pb) + 1); \
        if (IN((pb) + 2)) { \
            pg8::Gemm g{(const bf16*)(ws + WS_HID), (const bf16*)(ws + WS_WFFO) + (size_t)(l) * DM * FFH, MTOK, DM, FFH, FFH}; pg8::StaticOrder S; S.init(MTOK, DM, GG, (int)blockIdx.x); \
            pg8::EpiRes E{H, H, XN, ST}; \
            pg8::gemm_phase<pg8::EpiRes, pg8::StaticOrder, true, true>(ldsb + RING_OFF, g, S, E); \
        } SEAM((pb) + 2);
    LAYER_TAIL(0, 3)
    if (IN(6)) {
        pg8::Gemm g{XN, (const bf16*)(ws + WS_WNSA), MTOK, NSA_N, DM, DM}; pg8::StaticOrder S; S.init(MTOK, NSA_N, GG, (int)blockIdx.x);
        pg8::EpiNsa E{(bf16*)(ws + WS_Q), (bf16*)(ws + WS_KV), (bf16*)(ws + WS_XQ1), (float*)(ws + WS_GATES), ST};
        pg8::gemm_phase<pg8::EpiNsa, pg8::StaticOrder, true, true>(ldsb + RING_OFF, g, S, E);
    } SEAM(6);
    if (IN(7)) { MKF(); cmpmlp_phase(F, args); memattn_phase(F, args, 1, (const bf16*)(ws + WS_XQ1)); } SEAM(7);
    if (IN(8)) { MKF(); nsa_phase(F, args);
#ifdef PROBE_NSA2
        __syncthreads(); nsa_phase(F, args);
#endif
    } SEAM(8);
    LAYER_TAIL(1, 9)
#undef LAYER_TAIL
    if (IN(12)) { MKF(); p_final(F, args); }
#undef IN
#undef SEAM
}

static void launch_mega(const Args& base, int lo, int hi, int grid, hipStream_t stream, int li = 0) {
    Args a = base; a.ph_lo = lo; a.ph_hi = hi; a.li = li;
    hipLaunchKernelGGL(mega_fwd, dim3(grid), dim3(NWAVES * 64), LDS_BYTES, stream, a);
}
extern "C" void kernel_launch(void* const* d_in, const int* in_sizes, int n_in, void* d_out, int out_size, void* d_ws, size_t ws_size, hipStream_t stream) {
    static int grid = 0;
    if (grid == 0) {
        int dev = 0, cus = 0;
        if (n_in != 20 || out_size != MTOK * DM || ws_size < WS_END) { fprintf(stderr, "kernel_launch: unexpected shapes (n_in %d out %d ws %zu)\n", n_in, out_size, ws_size); grid = -1; return; }
        if (hipGetDevice(&dev) != hipSuccess || hipDeviceGetAttribute(&cus, hipDeviceAttributeMultiprocessorCount, dev) != hipSuccess) { grid = -1; return; }
        if (hipFuncSetAttribute((const void*)mega_fwd, hipFuncAttributeMaxDynamicSharedMemorySize, LDS_BYTES) != hipSuccess) { fprintf(stderr, "kernel_launch: hipFuncSetAttribute failed\n"); grid = -1; return; }
        grid = cus;
    }
    if (grid < 0) return;
    (void)hipMemsetAsync((char*)d_ws + WS_CTL, 0, CTL_ZERO_BYTES, stream);
    Args a{};
    for (int i = 0; i < 20; ++i) a.in[i] = (const float*)d_in[i];
    a.out = (float*)d_out; a.ws = (unsigned char*)d_ws;
    launch_mega(a, 0, 13, grid, stream, 0);
}
```

```cpp
#include <hip/hip_runtime.h>
#include <cstdio>
#include <cstdint>
#include <cmath>

namespace pg8 {
#define PG8_LAS __attribute__((address_space(3)))
typedef unsigned short bf16_t;
typedef short bf16x8 __attribute__((ext_vector_type(8)));
typedef float f32x4 __attribute__((ext_vector_type(4)));
typedef unsigned u32x4 __attribute__((ext_vector_type(4)));
constexpr int BM = 256, BK = 64, HALF = 128, HTB = HALF * BK * 2  , STAGE_BYTES = 8 * HTB, NXCD = 8, WGM = 8;

__host__ __device__ __forceinline__ int lds_byte(int r, int c) { const int st = (r >> 4) * 2 + (c >> 5), rr = r & 15, cc = c & 31, ob = rr * 64 + cc * 2; return st * 1024 + (ob ^ (((ob >> 9) & 1) << 5)); }
__host__ __device__ __forceinline__ void stage_rc(int b, int& R, int& C) { const int st = b / 1024, sb = b % 1024, swz = sb ^ (((sb >> 9) & 1) << 5); R = (st >> 1) * 16 + swz / 64; C = (st & 1) * 32 + (swz % 64) / 2; }
__host__ __device__ __forceinline__ int perm32(int rho) { const int n = rho >> 4, i = rho & 15; return 8 * (i >> 2) + 4 * n + (i & 3); }

struct Unit { int pm, pn; };
struct Gemm { const bf16_t* A; const bf16_t* Bt; int M, N, K, lda; };

struct StaticOrder {
    int nM, nN, nwg, G, c;
    __host__ __device__ void init(int M, int N, int G_, int c_) { nM = M / BM; nN = N / BM; nwg = nM * nN; G = G_; c = c_; }
    __host__ __device__ bool next(int i, Unit& u) const {
        const long L = (long)i * G + c; if (L >= nwg) return false;
        int wgid = (int)L; { const int q = nwg / NXCD, r = nwg % NXCD, xcd = wgid % NXCD, off = wgid / NXCD; wgid = (xcd < r ? xcd * (q + 1) : r * (q + 1) + (xcd - r) * q) + off; }
        const int nig = WGM * nN, gid = wgid / nig, fm = gid * WGM, gsz = (nM - fm) < WGM ? (nM - fm) : WGM;
        u.pm = fm + ((wgid % nig) % gsz); u.pn = (wgid % nig) / gsz; return true;
    }
    __device__ __forceinline__ void a_ready(const Unit&) const {}
    __device__ __forceinline__ void done(const Unit&) const {}
};


__device__ __forceinline__ unsigned cvt_pk_bf16(float lo, float hi) { unsigned r; asm volatile("v_cvt_pk_bf16_f32 %0, %1, %2" : "=v"(r) : "v"(lo), "v"(hi)); return r; }
__device__ __forceinline__ u32x4 pack8(const f32x4 v0, const f32x4 v1) { u32x4 w; w.x = cvt_pk_bf16(v0[0], v0[1]); w.y = cvt_pk_bf16(v0[2], v0[3]); w.z = cvt_pk_bf16(v1[0], v1[1]); w.w = cvt_pk_bf16(v1[2], v1[3]); return w; }
__device__ __forceinline__ float row_rstd(const float* __restrict__ stats, int row) {
    const f32x4* s = (const f32x4*)(stats + (size_t)row * 16);
    const f32x4 a = s[0], b = s[1], c = s[2], d = s[3];
    const float t = ((a[0] + a[1]) + (a[2] + a[3])) + ((b[0] + b[1]) + (b[2] + b[3])) + ((c[0] + c[1]) + (c[2] + c[3])) + ((d[0] + d[1]) + (d[2] + d[3]));
    return rsqrtf(t * (1.0f / 1024.0f) + 1e-6f);
}
__device__ __forceinline__ float silu_f(float g) { return g * __builtin_amdgcn_rcpf(1.0f + __builtin_amdgcn_exp2f(-1.4426950408889634f * g)); }
__device__ __forceinline__ float sigm_f(float g) { return __builtin_amdgcn_rcpf(1.0f + __builtin_amdgcn_exp2f(-1.4426950408889634f * g)); }

struct EpiMemKV {
    static constexpr bool PERM = true, AFTER_DRAIN = false;
    bf16_t* MK; bf16_t* MV;
    __device__ __forceinline__ void operator()(const f32x4 (&acc)[2][2][4][2], const Unit& u, int wr, int wc, int fr, int fq) const {
        const int la = u.pm >> 1, b = u.pm & 1, kv = (u.pn >> 1) & 1;
#pragma unroll
        for (int ai = 0; ai < 2; ++ai)
#pragma unroll
            for (int m = 0; m < 4; ++m) { const int key = ai * HALF + wr * 64 + m * 16 + fr;
#pragma unroll
                for (int bj = 0; bj < 2; ++bj) { const int head = (u.pn & 1) * 2 + bj, d = wc * 32 + 8 * fq;
                    bf16_t* base = (kv ? MV : MK) + (size_t)((la * 2 + b) * 4 + head) * 32768;
                    const size_t off = kv ? (size_t)(key >> 6) * 8192 + (d >> 5) * 2048 + (key & 63) * 32 + (d & 31) : (size_t)(key >> 6) * 8192 + (d >> 3) * 512 + (key & 63) * 8;
                    *(u32x4*)(base + off) = pack8(acc[ai][bj][m][0], acc[ai][bj][m][1]); } }
    }
};
struct DiagOrder {
    int G, c;
    __device__ bool next(int i, Unit& u) const { const int L = i * G + c; if (L >= 16) return false; const int la = L >> 3; u.pm = la * 2 + ((L >> 2) & 1); u.pn = la * 4 + (L & 3); return true; }
    __device__ __forceinline__ void a_ready(const Unit&) const {}
    __device__ __forceinline__ void done(const Unit&) const {}
};
struct EpiConv {
    static constexpr bool PERM = true, AFTER_DRAIN = false;
    bf16_t* UB; bf16_t* V; bf16_t* XQ; const float* stats;
    __device__ __forceinline__ void operator()(const f32x4 (&acc)[2][2][4][2], const Unit& u, int wr, int wc, int fr, int fq) const {
#pragma unroll
        for (int ai = 0; ai < 2; ++ai)
#pragma unroll
            for (int m = 0; m < 4; ++m) { const int row = u.pm * BM + ai * HALF + wr * 64 + m * 16 + fr; const float rs = row_rstd(stats, row);
                if (u.pn < 4) {
#pragma unroll
                    for (int bj = 0; bj < 2; ++bj) *(u32x4*)(UB + (size_t)row * 1024 + u.pn * BM + bj * HALF + wc * 32 + 8 * fq) = pack8(acc[ai][bj][m][0] * rs, acc[ai][bj][m][1] * rs);
                } else if (u.pn < 12) {
                    const float r2 = rs * rs;
                    *(u32x4*)(V + (size_t)row * 1024 + (u.pn - 4) * HALF + wc * 32 + 8 * fq) = pack8(acc[ai][0][m][0] * acc[ai][1][m][0] * r2, acc[ai][0][m][1] * acc[ai][1][m][1] * r2);
                } else {
#pragma unroll
                    for (int bj = 0; bj < 2; ++bj) *(u32x4*)(XQ + (size_t)row * 512 + (u.pn - 12) * BM + bj * HALF + wc * 32 + 8 * fq) = pack8(acc[ai][bj][m][0] * rs, acc[ai][bj][m][1] * rs);
                } }
    }
};
struct EpiSwiglu {
    static constexpr bool PERM = true, AFTER_DRAIN = false;
    bf16_t* HID; const float* stats;
    __device__ __forceinline__ void operator()(const f32x4 (&acc)[2][2][4][2], const Unit& u, int wr, int wc, int fr, int fq) const {
#pragma unroll
        for (int ai = 0; ai < 2; ++ai)
#pragma unroll
            for (int m = 0; m < 4; ++m) { const int row = u.pm * BM + ai * HALF + wr * 64 + m * 16 + fr; const float rs = row_rstd(stats, row);
                f32x4 o[2];
#pragma unroll
                for (int n = 0; n < 2; ++n)
#pragma unroll
                    for (int e = 0; e < 4; ++e) o[n][e] = silu_f(acc[ai][0][m][n][e] * rs) * (acc[ai][1][m][n][e] * rs);
                *(u32x4*)(HID + (size_t)row * 2816 + u.pn * HALF + wc * 32 + 8 * fq) = pack8(o[0], o[1]); }
    }
};
struct EpiNsa {
    static constexpr bool PERM = true, AFTER_DRAIN = false;
    bf16_t* Q; bf16_t* KV; bf16_t* XQ; float* GATES; const float* stats;
    __device__ __forceinline__ void operator()(const f32x4 (&acc)[2][2][4][2], const Unit& u, int wr, int wc, int fr, int fq) const {
#pragma unroll
        for (int ai = 0; ai < 2; ++ai)
#pragma unroll
            for (int m = 0; m < 4; ++m) { const int row = u.pm * BM + ai * HALF + wr * 64 + m * 16 + fr; const float rs = row_rstd(stats, row);
                if (u.pn < 4) {
#pragma unroll
                    for (int bj = 0; bj < 2; ++bj) *(u32x4*)(Q + (size_t)row * 1024 + u.pn * BM + bj * HALF + wc * 32 + 8 * fq) = pack8(acc[ai][bj][m][0] * rs, acc[ai][bj][m][1] * rs);
                } else if (u.pn < 10) {
                    const int b = row >> 13, s = row & 8191;
#pragma unroll
                    for (int bj = 0; bj < 2; ++bj) { const int ct = bj * HALF + wc * 32 + 8 * fq, g = ct >> 6, d = ct & 63, sl = u.pn - 4;
                        const size_t off = sl < 2 ? (size_t)s * 64 + d : ((sl & 1) ? (size_t)(s >> 6) * 4096 + (d >> 5) * 2048 + (s & 63) * 32 + (d & 31) : (size_t)(s >> 6) * 4096 + (d >> 3) * 512 + (s & 63) * 8);
                        *(u32x4*)(KV + ((size_t)sl * 8 + b * 4 + g) * 8192 * 64 + off) = pack8(acc[ai][bj][m][0] * rs, acc[ai][bj][m][1] * rs); }
                } else if (u.pn < 12) {
#pragma unroll
                    for (int bj = 0; bj < 2; ++bj) *(u32x4*)(XQ + (size_t)row * 512 + (u.pn - 10) * BM + bj * HALF + wc * 32 + 8 * fq) = pack8(acc[ai][bj][m][0] * rs, acc[ai][bj][m][1] * rs);
                } else {
                    const int ct = wc * 32 + 8 * fq;
                    if (ct < 48) { f32x4 g0, g1;
#pragma unroll
                        for (int e = 0; e < 4; ++e) { g0[e] = sigm_f(acc[ai][0][m][0][e] * rs); g1[e] = sigm_f(acc[ai][0][m][1][e] * rs); }
                        *(f32x4*)(GATES + (size_t)row * 48 + ct) = g0; *(f32x4*)(GATES + (size_t)row * 48 + ct + 4) = g1; }
                } }
    }
};
struct EpiRes {
    static constexpr bool PERM = true, AFTER_DRAIN = false;
    const float* base; float* out; bf16_t* xn; float* stats;
    __device__ __forceinline__ void operator()(const f32x4 (&acc)[2][2][4][2], const Unit& u, int wr, int wc, int fr, int fq) const {
#pragma unroll
        for (int ai = 0; ai < 2; ++ai)
#pragma unroll
            for (int m = 0; m < 4; ++m) { const int row = u.pm * BM + ai * HALF + wr * 64 + m * 16 + fr; float ss = 0.f;
#pragma unroll
                for (int bj = 0; bj < 2; ++bj) { const size_t off = (size_t)row * 1024 + u.pn * BM + bj * HALF + wc * 32 + 8 * fq;
                    const f32x4 v0 = *(const f32x4*)(base + off) + acc[ai][bj][m][0], v1 = *(const f32x4*)(base + off + 4) + acc[ai][bj][m][1];
                    *(f32x4*)(out + off) = v0; *(f32x4*)(out + off + 4) = v1; *(u32x4*)(xn + off) = pack8(v0, v1);
                    ss += (v0[0] * v0[0] + v0[1] * v0[1]) + (v0[2] * v0[2] + v0[3] * v0[3]) + (v1[0] * v1[0] + v1[1] * v1[1]) + (v1[2] * v1[2] + v1[3] * v1[3]); }
                ss += __shfl_xor(ss, 16); ss += __shfl_xor(ss, 32);
                if (fq == 0) stats[(size_t)row * 16 + u.pn * 4 + wc] = ss; }
    }
};

template <class Epi, class Sched, bool ALIGN_EPI = false, bool SP2 = false>
__device__ __forceinline__ void gemm_phase(PG8_LAS unsigned char* lds, const Gemm g, const Sched& S, const Epi& E) {
    const int tid = threadIdx.x, wid = __builtin_amdgcn_readfirstlane(tid >> 6), lane = tid & 63, wr = wid >> 2, wc = wid & 3, fr = lane & 15, fq = lane >> 4;
    const int K = g.K, nt = K / BK;
    unsigned voffA[2], voffB[2];
#pragma unroll
    for (int i = 0; i < 2; ++i) { int R, C; stage_rc(tid * 16 + i * 8192, R, C); const int Rb = Epi::PERM ? ((R & ~31) + perm32(R & 31)) : R;
        voffA[i] = (unsigned)(R * g.lda + C) * 2u; voffB[i] = (unsigned)(Rb * K + C) * 2u; }
    const size_t kstep = (size_t)(BK * 2);
    const size_t hstepB = (size_t)HALF * K * 2, hstepA = (size_t)HALF * g.lda * 2;
    const size_t tstepB = 2 * hstepB, tstepA = 2 * hstepA;
    const unsigned ldsw = (unsigned)wid * 1024u;
    const int aoff = lds_byte(wr * 64 + fr, fq * 8), boff = lds_byte(wc * 32 + fr, fq * 8);
#define PG8_SA(b, h) (((b) * 2 + (h)) * HTB)
#define PG8_SB(b, h) ((4 + (b) * 2 + (h)) * HTB)
#define PG8_STAGE(bufoff, gbase, voff) do { _Pragma("unroll") for (int _i = 0; _i < 2; ++_i) \
        __builtin_amdgcn_global_load_lds((const unsigned*)((const char*)(gbase) + (voff)[_i]), (PG8_LAS unsigned*)(lds + (bufoff) + ldsw + _i * 8192), 16, 0, 0); } while (0)
#define PG8_LDA(dst, b, h) do { _Pragma("unroll") for (int m = 0; m < 4; ++m) _Pragma("unroll") for (int k = 0; k < 2; ++k) dst[m][k] = *(const PG8_LAS bf16x8*)(lds + PG8_SA(b, h) + aoff + m * 2048 + k * 1024); } while (0)
#define PG8_LDB(dst, b, h) do { _Pragma("unroll") for (int n = 0; n < 2; ++n) _Pragma("unroll") for (int k = 0; k < 2; ++k) dst[n][k] = *(const PG8_LAS bf16x8*)(lds + PG8_SB(b, h) + boff + n * 2048 + k * 1024); } while (0)
#define PG8_MMA(ai, bj, At, Bt) do { __builtin_amdgcn_s_setprio(1); _Pragma("unroll") for (int m = 0; m < 4; ++m) _Pragma("unroll") for (int n = 0; n < 2; ++n) _Pragma("unroll") for (int k = 0; k < 2; ++k) \
        acc[ai][bj][m][n] = __builtin_amdgcn_mfma_f32_16x16x32_bf16(Bt[n][k], At[m][k], acc[ai][bj][m][n], 0, 0, 0); __builtin_amdgcn_s_setprio(0); } while (0)
#define PG8_WAIT_V(n) asm volatile("s_waitcnt vmcnt(" #n ")" ::: "memory")
#define PG8_WAIT_L(n) asm volatile("s_waitcnt lgkmcnt(" #n ")" ::: "memory")
#define PG8_BAR __builtin_amdgcn_s_barrier()
#define PG8_SCHED __builtin_amdgcn_sched_barrier(0)
    Unit cur, nxt; int ui = 0;
    if (!S.next(0, cur)) return;
    f32x4 acc[2][2][4][2];
#pragma unroll
    for (int a = 0; a < 2; ++a)
#pragma unroll
        for (int b = 0; b < 2; ++b)
#pragma unroll
            for (int m = 0; m < 4; ++m)
#pragma unroll
                for (int n = 0; n < 2; ++n) acc[a][b][m][n] = (f32x4){0.f, 0.f, 0.f, 0.f};
    bf16x8 At[4][2], B0[2][2], B1[2][2];
    const char* cA = (const char*)g.A + (size_t)cur.pm * tstepA; const char* cB = (const char*)g.Bt + (size_t)cur.pn * tstepB;
    S.a_ready(cur);
    if constexpr (SP2) {
        PG8_STAGE(PG8_SB(0, 0), cB, voffB); PG8_STAGE(PG8_SB(0, 1), cB + hstepB, voffB); PG8_STAGE(PG8_SA(0, 0), cA, voffA); PG8_STAGE(PG8_SA(0, 1), cA + hstepA, voffA);
        if (wr == 1) PG8_BAR;
        PG8_WAIT_V(2); PG8_BAR;
        PG8_STAGE(PG8_SB(1, 0), cB + kstep, voffB); PG8_STAGE(PG8_SA(1, 0), cA + kstep, voffA); PG8_STAGE(PG8_SB(1, 1), cB + hstepB + kstep, voffB);
        PG8_WAIT_V(6); PG8_BAR;
    } else {
        PG8_STAGE(PG8_SB(0, 0), cB, voffB); PG8_STAGE(PG8_SA(0, 0), cA, voffA); PG8_STAGE(PG8_SB(0, 1), cB + hstepB, voffB); PG8_STAGE(PG8_SA(0, 1), cA + hstepA, voffA);
        if (wr == 1) PG8_BAR;
        PG8_WAIT_V(4); PG8_BAR;
        PG8_STAGE(PG8_SB(1, 0), cB + kstep, voffB); PG8_STAGE(PG8_SA(1, 0), cA + kstep, voffA); PG8_STAGE(PG8_SB(1, 1), cB + hstepB + kstep, voffB);
        PG8_WAIT_V(6); PG8_BAR;
    }
    for (;;) {
        const bool has_next = S.next(ui + 1, nxt);
        const char* nA = has_next ? (const char*)g.A + (size_t)nxt.pm * tstepA : cA; const char* nB = has_next ? (const char*)g.Bt + (size_t)nxt.pn * tstepB : cB;
        for (int t = 0; t < nt; t += 2) {
            const bool last = (t == nt - 2);
            const char* a1 = cA + (size_t)(t + 1) * kstep;
            const char* a2 = last ? nA : cA + (size_t)(t + 2) * kstep; const char* b2 = last ? nB : cB + (size_t)(t + 2) * kstep;
            const char* a3 = a2 + kstep; const char* b3 = b2 + kstep;
            if (last && has_next) S.a_ready(nxt);
            if constexpr (SP2) {
            PG8_LDB(B0, 0, 0); PG8_LDB(B1, 0, 1); PG8_SCHED; PG8_LDA(At, 0, 0); PG8_STAGE(PG8_SA(1, 1), a1 + hstepA, voffA);
            PG8_WAIT_V(8); PG8_WAIT_L(0); PG8_BAR; PG8_MMA(0, 0, At, B0); PG8_MMA(0, 1, At, B1); PG8_BAR; PG8_SCHED;
            PG8_LDA(At, 0, 1); PG8_STAGE(PG8_SB(0, 0), b2, voffB); PG8_STAGE(PG8_SB(0, 1), b2 + hstepB, voffB); PG8_STAGE(PG8_SA(0, 0), a2, voffA);
            PG8_WAIT_V(8); PG8_WAIT_L(0); PG8_BAR; PG8_MMA(1, 0, At, B0); PG8_MMA(1, 1, At, B1); PG8_BAR; PG8_SCHED;
            PG8_LDB(B0, 1, 0); PG8_LDB(B1, 1, 1); PG8_SCHED; PG8_LDA(At, 1, 0); PG8_STAGE(PG8_SA(0, 1), a2 + hstepA, voffA);
            PG8_WAIT_V(8); PG8_WAIT_L(0); PG8_BAR; PG8_MMA(0, 0, At, B0); PG8_MMA(0, 1, At, B1); PG8_BAR; PG8_SCHED;
            PG8_LDA(At, 1, 1); PG8_STAGE(PG8_SB(1, 0), b3, voffB); PG8_STAGE(PG8_SB(1, 1), b3 + hstepB, voffB); PG8_STAGE(PG8_SA(1, 0), a3, voffA);
            PG8_WAIT_V(8); PG8_WAIT_L(0); PG8_BAR; PG8_MMA(1, 0, At, B0); PG8_MMA(1, 1, At, B1); PG8_BAR; PG8_SCHED;
            } else {
            PG8_LDB(B0, 0, 0); PG8_SCHED; PG8_LDA(At, 0, 0); PG8_STAGE(PG8_SA(1, 1), a1 + hstepA, voffA);
            PG8_WAIT_L(8); PG8_BAR; PG8_WAIT_L(0); PG8_MMA(0, 0, At, B0); PG8_BAR; PG8_SCHED;
            PG8_LDB(B1, 0, 1); PG8_STAGE(PG8_SB(0, 0), b2, voffB);
            PG8_BAR; PG8_WAIT_L(0); PG8_MMA(0, 1, At, B1); PG8_BAR;
            PG8_LDA(At, 0, 1); PG8_STAGE(PG8_SA(0, 0), a2, voffA);
            PG8_BAR; PG8_WAIT_L(0); PG8_MMA(1, 0, At, B0); PG8_BAR; PG8_SCHED;
            PG8_STAGE(PG8_SB(0, 1), b2 + hstepB, voffB);
            PG8_WAIT_V(6); PG8_BAR; PG8_MMA(1, 1, At, B1); PG8_BAR;
            PG8_LDB(B0, 1, 0); PG8_SCHED; PG8_LDA(At, 1, 0); PG8_STAGE(PG8_SA(0, 1), a2 + hstepA, voffA);
            PG8_WAIT_L(8); PG8_BAR; PG8_WAIT_L(0); PG8_MMA(0, 0, At, B0); PG8_BAR; PG8_SCHED;
            PG8_LDB(B1, 1, 1); PG8_STAGE(PG8_SB(1, 0), b3, voffB);
            PG8_BAR; PG8_WAIT_L(0); PG8_MMA(0, 1, At, B1); PG8_BAR;
            PG8_LDA(At, 1, 1); PG8_STAGE(PG8_SA(1, 0), a3, voffA);
            PG8_BAR; PG8_WAIT_L(0); PG8_MMA(1, 0, At, B0); PG8_BAR; PG8_SCHED;
            PG8_STAGE(PG8_SB(1, 1), b3 + hstepB, voffB);
            PG8_WAIT_V(6); PG8_BAR; PG8_MMA(1, 1, At, B1); PG8_BAR;
            }
        }
        if constexpr (ALIGN_EPI) { if (wr == 0) PG8_BAR; }
        if constexpr (!Epi::AFTER_DRAIN) { E(acc, cur, wr, wc, fr, fq); S.done(cur); }
        if (!has_next) break;
#pragma unroll
        for (int a = 0; a < 2; ++a)
#pragma unroll
            for (int b = 0; b < 2; ++b)
#pragma unroll
                for (int m = 0; m < 4; ++m)
#pragma unroll
                    for (int n = 0; n < 2; ++n) acc[a][b][m][n] = (f32x4){0.f, 0.f, 0.f, 0.f};
        cur = nxt; cA = nA; cB = nB; ++ui;
        if constexpr (ALIGN_EPI) { if (wr == 1) PG8_BAR; }
    }
    PG8_WAIT_V(0);
    if constexpr (!ALIGN_EPI) { if (wr == 0) PG8_BAR; }
    PG8_BAR;
    if constexpr (Epi::AFTER_DRAIN) { E.fused(acc, cur, wr, wc, fr, fq, lds, wid, lane); S.done(cur); }
#undef PG8_SA
#undef PG8_SB
#undef PG8_STAGE
#undef PG8_LDA
#undef PG8_LDB
#undef PG8_MMA
#undef PG8_WAIT_V
#undef PG8_WAIT_L
#undef PG8_BAR
#undef PG8_SCHED
}
}
#define GAS __attribute__((address_space(1)))
#define LAS __attribute__((address_space(3)))
typedef unsigned short bf16;
typedef unsigned v4u __attribute__((ext_vector_type(4)));
typedef float f32x4 __attribute__((ext_vector_type(4)));
typedef short bf16x8 __attribute__((ext_vector_type(8)));
typedef GAS unsigned gu32;
typedef GAS unsigned long long gu64;
#define RLX_AGENT __ATOMIC_RELAXED, __HIP_MEMORY_SCOPE_AGENT
#define LDS_WAIT() asm volatile("s_waitcnt lgkmcnt(0)" ::: "memory")
#define VM_WAIT() asm volatile("s_waitcnt vmcnt(0)" ::: "memory")
__device__ __forceinline__ unsigned long long rt() { return __builtin_amdgcn_s_memrealtime(); }
__device__ __forceinline__ unsigned f2bf(float f) { unsigned u = __builtin_bit_cast(unsigned, f); return (u + 0x7fffu + ((u >> 16) & 1u)) >> 16; }
__device__ __forceinline__ unsigned pk2(float lo, float hi) { return f2bf(lo) | (f2bf(hi) << 16); }

#define XB_TMO      128
#define XB_XCNT(j)  (256  + 64 * (j))
#define XB_XSUB(j)  (1280 + 64 * (j))
#define XB_XGEN(j)  (2304 + 64 * (j))
#define XB_TOP      3328
#define XB_TOPGEN   3392
#define XCD_BAR_WORDS 3456
#define XB_SPIN_CAP (1u << 18)

__device__ __forceinline__ unsigned xb_ld(unsigned* p)              { return __hip_atomic_load(p, __ATOMIC_RELAXED, __HIP_MEMORY_SCOPE_AGENT); }
__device__ __forceinline__ unsigned xb_add(unsigned* p, unsigned v) { return __hip_atomic_fetch_add(p, v, __ATOMIC_RELAXED, __HIP_MEMORY_SCOPE_AGENT); }
__device__ __forceinline__ unsigned xb_xcc_id() { return (unsigned)__builtin_amdgcn_s_getreg((3 << 11) | 20) & 0xFu; }
#define XB_SPIN(cond, bar) do { unsigned _sp = 0; while (cond) { __builtin_amdgcn_s_sleep(1); \
    if ((++_sp & 255u) == 0u) { if (xb_ld(&(bar)[XB_TMO])) break; if (_sp > XB_SPIN_CAP) { atomicAdd(&(bar)[XB_TMO], 1u); break; } } } } while (0)

struct XcdBarrier {
    unsigned* bar; unsigned x;
    volatile LAS unsigned* st;
};

__device__ __forceinline__ XcdBarrier xcd_barrier_post(unsigned* bar, volatile LAS unsigned* st) {
    XcdBarrier b; b.bar = bar; b.x = xb_xcc_id(); b.st = st;
    if (threadIdx.x == 0) (void)xb_add(&bar[XB_XCNT(b.x)], 1u);
    return b;
}
__device__ __forceinline__ void xcd_barrier_complete(unsigned* bar, unsigned x, unsigned& nloc, unsigned& nx) {
    const unsigned G = gridDim.x * gridDim.y * gridDim.z;
    unsigned sum, cnt, mine, sp = 0u;
    for (;;) {
        sum = 0u; cnt = 0u; mine = 0u;
#pragma unroll
        for (unsigned j = 0; j < 16; ++j) { const unsigned c = xb_ld(&bar[XB_XCNT(j)]); sum += c; cnt += (c > 0u) ? 1u : 0u; mine = (j == x) ? c : mine; }
        if (sum == G) break;
        __builtin_amdgcn_s_sleep(1);
        if ((++sp & 255u) == 0u) { if (xb_ld(&bar[XB_TMO])) break; if (sp > XB_SPIN_CAP) { atomicAdd(&bar[XB_TMO], 1u); break; } }
    }
    nloc = mine > 0u ? mine : 1u; nx = cnt > 0u ? cnt : 1u;
}

__device__ __forceinline__ void xcd_barrier(const XcdBarrier& b) {
    asm volatile("s_waitcnt vmcnt(0)" ::: "memory");
    __syncthreads();
    if (threadIdx.x == 0) {
        unsigned* bar = b.bar;
        __builtin_amdgcn_s_waitcnt(0);
        unsigned nloc = b.st[0], nx = b.st[1];
        if (nloc == 0u) { xcd_barrier_complete(bar, b.x, nloc, nx); b.st[0] = nloc; b.st[1] = nx; }
        const unsigned old = xb_add(&bar[XB_XSUB(b.x)], 1u);
        const unsigned gen = old / nloc;
        if (old + 1u == (gen + 1u) * nloc) {
            __builtin_amdgcn_fence(__ATOMIC_RELEASE, "agent");
            asm volatile("s_waitcnt vmcnt(0)" ::: "memory");
            const unsigned og = xb_add(&bar[XB_TOP], 1u);
            const unsigned tg = og / nx;
            if (og + 1u == (tg + 1u) * nx) xb_add(&bar[XB_TOPGEN], 1u);
            else XB_SPIN(xb_ld(&bar[XB_TOPGEN]) == tg, bar);
            __builtin_amdgcn_fence(__ATOMIC_ACQUIRE, "agent");
            xb_add(&bar[XB_XGEN(b.x)], 1u);
            asm volatile("s_waitcnt vmcnt(0)" ::: "memory");
        } else {
            XB_SPIN(xb_ld(&bar[XB_XGEN(b.x)]) == gen, bar);
            __builtin_amdgcn_fence(__ATOMIC_ACQUIRE, "agent");
            asm volatile("s_waitcnt vmcnt(0)" ::: "memory");
        }
    }
    __syncthreads();
}

constexpr int NWAVES = 8;
constexpr int BATCH = 2, SEQ = 8192, DM = 1024, MTOK = BATCH * SEQ, NMEM = 256, FFH = 2816, MIXW = 1536, XW = 512;
constexpr int CONV_N = 3584, NSA_N = 3328, NSA_SRC = 3120, NCMP = 511;
constexpr size_t MiB = 1u << 20;
constexpr size_t WS_CTL = 0, CTL_ZERO_BYTES = 1 * MiB;
constexpr size_t WS_STATS = 1 * MiB;
constexpr size_t WS_TAB = 2 * MiB;
constexpr size_t WS_MEMN = 3 * MiB;
constexpr size_t WS_KVM = 5 * MiB;
constexpr size_t WS_CMP = 9 * MiB;
constexpr size_t WS_GATES = 11 * MiB;
constexpr size_t WS_WCONV = 14 * MiB;
constexpr size_t WS_WNSA = 21 * MiB;
constexpr size_t WS_WOUT = 28 * MiB;
constexpr size_t WS_WFFI = 34 * MiB;
constexpr size_t WS_WFFO = 56 * MiB;
constexpr size_t WS_WMKV = 67 * MiB;
constexpr size_t WS_WC1 = 71 * MiB;
constexpr size_t WS_WC2 = 72 * MiB;
constexpr size_t WS_XN = 73 * MiB;
constexpr size_t WS_MIX = 105 * MiB;
constexpr size_t WS_UNION = 153 * MiB;
constexpr size_t WS_UB = WS_UNION, WS_V = WS_UNION + 32 * MiB, WS_XQ0 = WS_UNION + 64 * MiB;
constexpr size_t WS_HID = WS_UNION;
constexpr size_t WS_Q = WS_UNION, WS_KV = WS_UNION + 32 * MiB, WS_XQ1 = WS_UNION + 82 * MiB;
constexpr size_t WS_END = 253 * MiB;
static_assert(WS_XQ1 + 16 * MiB <= WS_END && WS_HID + 88 * MiB <= WS_END, "ws map");
constexpr int CW_BAR = 4096;

constexpr int RING_OFF = 0, RING_BYTES = 155648;
constexpr int LDSCTL_OFF = RING_BYTES, MISC_OFF = LDSCTL_OFF + 320;
constexpr int LDS_BYTES = 159744;

struct Frame {
    LAS unsigned char* lds;
    volatile LAS unsigned* MISC;
    gu32* ctl;
    int tid, lane, wave, vcu, G;
};
__device__ __forceinline__ float wave_sum(float v) {
#pragma unroll
    for (int o = 1; o < 64; o <<= 1) v += __shfl_xor(v, o);
    return v;
}
struct Args { const float* in[20]; float* out; unsigned char* ws; int ph_lo, ph_hi, li, pad; };

__device__ __forceinline__ Frame mk_frame(unsigned char* ldsraw, unsigned char* ws) {
    Frame F; F.lds = (LAS unsigned char*)ldsraw; F.MISC = (volatile LAS unsigned*)(F.lds + MISC_OFF);
    int t = threadIdx.x; asm volatile("" : "+v"(t)); F.tid = t; F.lane = t & 63; F.wave = __builtin_amdgcn_readfirstlane(t >> 6);
    F.G = gridDim.x; { const int bx = blockIdx.x; F.vcu = (F.G % 8 == 0) ? (bx % 8) * (F.G / 8) + bx / 8 : bx; }
    F.ctl = (gu32*)(ws + WS_CTL); return F;
}

namespace att {
typedef float f32x16 __attribute__((ext_vector_type(16)));
typedef short s16x4 __attribute__((ext_vector_type(4)));
typedef short v4i16_t __attribute__((ext_vector_type(4)));
typedef __attribute__((address_space(3))) const unsigned char* lcp;
constexpr float LOG2E = 1.4426950408889634f;
constexpr float NEG_BIG = -1.0e30f;
__device__ __forceinline__ unsigned cvtpk(float lo, float hi) { typedef float f2 __attribute__((ext_vector_type(2))); typedef __bf16 b2 __attribute__((ext_vector_type(2))); f2 v = {lo, hi}; b2 b = __builtin_convertvector(v, b2); return __builtin_bit_cast(unsigned, b); }
__device__ __forceinline__ float xhalf_max(float m) { auto rr = __builtin_amdgcn_permlane32_swap(__float_as_uint(m), __float_as_uint(m), false, false); return fmaxf(__uint_as_float(rr[0]), __uint_as_float(rr[1])); }
__device__ __forceinline__ float xhalf_sum(float m) { auto rr = __builtin_amdgcn_permlane32_swap(__float_as_uint(m), __float_as_uint(m), false, false); return __uint_as_float(rr[0]) + __uint_as_float(rr[1]); }
__device__ __forceinline__ s16x4 vtr(lcp p) { return __builtin_bit_cast(s16x4, __builtin_amdgcn_ds_read_tr16_b64_v4i16((__attribute__((address_space(3))) v4i16_t*)p)); }

template <int NB> __device__ __forceinline__ void dma_tile(const void* gsrc, LAS unsigned char* slot, int wave, int lane) {
#pragma unroll
    for (int i = 0; i < NB / 8192; ++i)
        __builtin_amdgcn_global_load_lds((const unsigned*)((const unsigned char*)gsrc + (i * 8 + wave) * 1024 + lane * 16), (LAS unsigned*)(slot + (i * 8 + wave) * 1024), 16, 0, 0);
}
template <int D> __device__ __forceinline__ void qk_tile(f32x16& p0, f32x16& p1, lcp Kslot, const bf16x8 (&q)[D / 16], int r, int hh) {
    lcp kb = Kslot + hh * 1024 + r * 16;
    p0 = (f32x16){0.f}; p1 = (f32x16){0.f};
#pragma unroll
    for (int ks = 0; ks < D / 16; ++ks) {
        const bf16x8 a0 = *(const LAS bf16x8*)(kb + ks * 2048), a1 = *(const LAS bf16x8*)(kb + ks * 2048 + 512);
        p0 = __builtin_amdgcn_mfma_f32_32x32x16_bf16(a0, q[ks], p0, 0, 0, 0);
        p1 = __builtin_amdgcn_mfma_f32_32x32x16_bf16(a1, q[ks], p1, 0, 0, 0);
    }
}
template <int D> __device__ __forceinline__ void pv_tile(f32x16 (&o)[D / 32], lcp Vslot, const f32x16& p0, const f32x16& p1, int lane) {
    const int hh = lane >> 5;
    lcp vb = Vslot + ((lane >> 4) & 1) * 32 + (lane & 3) * 8 + (4 * hh + ((lane & 15) >> 2)) * 64;
    v4u pw[4];
    pw[0] = (v4u){cvtpk(p0[0], p0[1]), cvtpk(p0[2], p0[3]), cvtpk(p0[4], p0[5]), cvtpk(p0[6], p0[7])};
    pw[1] = (v4u){cvtpk(p0[8], p0[9]), cvtpk(p0[10], p0[11]), cvtpk(p0[12], p0[13]), cvtpk(p0[14], p0[15])};
    pw[2] = (v4u){cvtpk(p1[0], p1[1]), cvtpk(p1[2], p1[3]), cvtpk(p1[4], p1[5]), cvtpk(p1[6], p1[7])};
    pw[3] = (v4u){cvtpk(p1[8], p1[9]), cvtpk(p1[10], p1[11]), cvtpk(p1[12], p1[13]), cvtpk(p1[14], p1[15])};
#pragma unroll
    for (int d0 = 0; d0 < D / 32; ++d0)
#pragma unroll
        for (int s = 0; s < 4; ++s) {
            const s16x4 lo = vtr(vb + d0 * 4096 + s * 1024), hi = vtr(vb + d0 * 4096 + s * 1024 + 512);
            const bf16x8 vf = (bf16x8){lo[0], lo[1], lo[2], lo[3], hi[0], hi[1], hi[2], hi[3]};
            o[d0] = __builtin_amdgcn_mfma_f32_32x32x16_bf16(vf, __builtin_bit_cast(bf16x8, pw[s]), o[d0], 0, 0, 0);
        }
}
template <int ND> __device__ __forceinline__ void softmax_step(f32x16& p0, f32x16& p1, float& m, float& l, f32x16 (&o)[ND]) {
    float mx = fmaxf(p0[0], p1[0]);
#pragma unroll
    for (int i = 1; i < 16; ++i) mx = fmaxf(mx, fmaxf(p0[i], p1[i]));
    mx = xhalf_max(mx);
    const float mn = fmaxf(m, mx);
    const float alpha = __builtin_amdgcn_exp2f(m - mn);
    float s = 0.f;
#pragma unroll
    for (int i = 0; i < 16; ++i) { p0[i] = p0[i] > -1.0e29f ? __builtin_amdgcn_exp2f(p0[i] - mn) : 0.f; p1[i] = p1[i] > -1.0e29f ? __builtin_amdgcn_exp2f(p1[i] - mn) : 0.f; s += p0[i] + p1[i]; }
    l = l * alpha + s; m = mn;
#pragma unroll
    for (int d = 0; d < ND; ++d) o[d] = o[d] * alpha;
}
}

constexpr size_t WS_MKI = 5 * MiB;
constexpr size_t WS_MVI = 6 * MiB;
constexpr size_t WS_KCI = 9 * MiB;
constexpr size_t WS_VCI = 10 * MiB;
constexpr size_t TAB_BIAS2 = 0;
constexpr size_t TAB_POSB = 16384;
__device__ const unsigned char T5TAB[128] = {0, 1, 2, 3, 4, 5, 6, 7, 8, 9, 10, 11, 12, 13, 14, 15, 16, 16, 16, 17, 17, 18, 18, 18, 19, 19, 19, 20, 20, 20, 20, 21, 21, 21, 21, 22, 22, 22, 22, 22, 23, 23, 23, 23, 23, 23, 24, 24, 24, 24, 24, 24, 25, 25, 25, 25, 25, 25, 25, 26, 26, 26, 26, 26, 26, 26, 26, 27, 27, 27, 27, 27, 27, 27, 27, 27, 27, 28, 28, 28, 28, 28, 28, 28, 28, 28, 28, 29, 29, 29, 29, 29, 29, 29, 29, 29, 29, 29, 29, 30, 30, 30, 30, 30, 30, 30, 30, 30, 30, 30, 30, 30, 30, 31, 31, 31, 31, 31, 31, 31, 31, 31, 31, 31, 31, 31, 31, 31};

__device__ __forceinline__ void p0_tables(Frame& F, const Args& a) {
    const int gw = F.vcu * NWAVES + F.wave;
    float* tab = (float*)(a.ws + WS_TAB);
    if (gw < 32) {
        const int h = gw >> 1, d = (gw & 1) * 64 + F.lane;
        tab[TAB_BIAS2 / 4 + h * 128 + d] = a.in[15][(int)T5TAB[d] * 16 + h] * att::LOG2E;
    } else if (gw < 64) {
        const int it = gw - 32, kq = it >> 2, kv = (it >> 1) & 1, n = (it & 1) * 64 + F.lane;
        const float* pos = a.in[kv ? 12 : 9]; const float* w1 = a.in[kv ? 13 : 10];
        float s = 0.f;
        for (int k = kq * 256; k < kq * 256 + 256; ++k) s += pos[k] * w1[(size_t)k * 128 + n];
        tab[TAB_POSB / 4 + (kq * 2 + kv) * 128 + n] = s;
    }
}

__device__ __forceinline__ void conv_phase(Frame& F, const Args& a) {
    const bf16* UB = (const bf16*)(a.ws + WS_UB); const bf16* V = (const bf16*)(a.ws + WS_V); bf16* MIX = (bf16*)(a.ws + WS_MIX); const float* cw = a.in[7];
    for (int blk = F.vcu; blk < MTOK / 64; blk += F.G) {
        for (int idx = F.tid; idx < 64 * 128; idx += NWAVES * 64) {
            const int t = blk * 64 + (idx >> 7), c = (idx & 127) * 8, tl = t & (SEQ - 1);
            const bf16x8 ub = *(const bf16x8*)(UB + (size_t)t * DM + c), v2 = *(const bf16x8*)(V + (size_t)t * DM + c);
            bf16x8 v1 = (bf16x8){0, 0, 0, 0, 0, 0, 0, 0}, v0 = v1;
            if (tl >= 1) v1 = *(const bf16x8*)(V + (size_t)(t - 1) * DM + c);
            if (tl >= 2) v0 = *(const bf16x8*)(V + (size_t)(t - 2) * DM + c);
            const f32x4 wa0 = *(const f32x4*)(cw + c), wa1 = *(const f32x4*)(cw + c + 4), wb0 = *(const f32x4*)(cw + DM + c), wb1 = *(const f32x4*)(cw + DM + c + 4), wc0 = *(const f32x4*)(cw + 2 * DM + c), wc1 = *(const f32x4*)(cw + 2 * DM + c + 4);
            float o[8];
#pragma unroll
            for (int e = 0; e < 8; ++e) { const float w0 = e < 4 ? wa0[e & 3] : wa1[e & 3], w1 = e < 4 ? wb0[e & 3] : wb1[e & 3], w2 = e < 4 ? wc0[e & 3] : wc1[e & 3];
                const float f0 = __uint_as_float((unsigned)(unsigned short)v0[e] << 16), f1 = __uint_as_float((unsigned)(unsigned short)v1[e] << 16), f2 = __uint_as_float((unsigned)(unsigned short)v2[e] << 16), fb = __uint_as_float((unsigned)(unsigned short)ub[e] << 16);
                o[e] = fb * (w0 * f0 + w1 * f1 + w2 * f2); }
            v4u w; w.x = att::cvtpk(o[0], o[1]); w.y = att::cvtpk(o[2], o[3]); w.z = att::cvtpk(o[4], o[5]); w.w = att::cvtpk(o[6], o[7]);
            *(v4u*)(MIX + (size_t)t * MIXW + c) = w;
        }
    }
}

__device__ __forceinline__ void memattn_phase(Frame& F, const Args& a, int layer, const bf16* XQ) {
    using namespace att;
    bf16* MIX = (bf16*)(a.ws + WS_MIX);
    const int lane = F.lane, r = lane & 31, hh = lane >> 5;
    LAS unsigned char* Ks = F.lds + RING_OFF; LAS unsigned char* Vs = F.lds + RING_OFF + 32768;
    for (int u = F.vcu; u < 256; u += F.G) {
        const int b = u >> 7, head = (u >> 5) & 3, qb = u & 31;
        const unsigned char* Kimg = a.ws + WS_MKI + (size_t)((layer * 2 + b) * 4 + head) * 65536; const unsigned char* Vimg = a.ws + WS_MVI + (size_t)((layer * 2 + b) * 4 + head) * 65536;
        const size_t row = (size_t)b * SEQ + qb * 256 + F.wave * 32 + r;
        bf16x8 q[8];
#pragma unroll
        for (int ks = 0; ks < 8; ++ks) q[ks] = *(const bf16x8*)(XQ + row * XW + head * 128 + 16 * ks + 8 * hh);
        f32x16 o[4]; o[0] = (f32x16){0.f}; o[1] = o[0]; o[2] = o[0]; o[3] = o[0];
        float m = NEG_BIG, l = 0.f;
        dma_tile<16384>(Kimg, Ks, F.wave, lane); dma_tile<16384>(Vimg, Vs, F.wave, lane);
#pragma unroll 1
        for (int t = 0; t < 4; ++t) {
            asm volatile("s_waitcnt vmcnt(0)" ::: "memory"); __syncthreads();
            if (t + 1 < 4) { dma_tile<16384>(Kimg + (t + 1) * 16384, Ks + ((t + 1) & 1) * 16384, F.wave, lane); dma_tile<16384>(Vimg + (t + 1) * 16384, Vs + ((t + 1) & 1) * 16384, F.wave, lane); }
            f32x16 p0, p1;
            qk_tile<128>(p0, p1, (lcp)(Ks + (t & 1) * 16384), q, r, hh);
            const float sc = 0.08838834764831845f * LOG2E;
#pragma unroll
            for (int i = 0; i < 16; ++i) { p0[i] *= sc; p1[i] *= sc; }
            softmax_step<4>(p0, p1, m, l, o);
            pv_tile<128>(o, (lcp)(Vs + (t & 1) * 16384), p0, p1, lane);
        }
        l = xhalf_sum(l); const float inv = 1.f / l;
        bf16* orow = MIX + row * MIXW + 1024 + head * 128 + 4 * hh;
#pragma unroll
        for (int d0 = 0; d0 < 4; ++d0)
#pragma unroll
            for (int i4 = 0; i4 < 4; ++i4) { typedef unsigned u32x2 __attribute__((ext_vector_type(2)));
                u32x2 w; w.x = cvtpk(o[d0][4 * i4] * inv, o[d0][4 * i4 + 1] * inv); w.y = cvtpk(o[d0][4 * i4 + 2] * inv, o[d0][4 * i4 + 3] * inv);
                *(u32x2*)(orow + 32 * d0 + 8 * i4) = w; }
        __syncthreads();
    }
}

__device__ __forceinline__ void cmpmlp_phase(Frame& F, const Args& a) {
    using namespace att;
    const int lane = F.lane, r = lane & 31, hh = lane >> 5, rh = F.wave >> 2, ct = F.wave & 3;
    const float* tab = (const float*)(a.ws + WS_TAB);
    LAS unsigned short* HM = (LAS unsigned short*)(F.lds + RING_OFF);
    for (int u = F.vcu; u < 128; u += F.G) {
        const int kv = u >> 6, bg = (u >> 3) & 7, rb = u & 7;
        const bf16* raw = (const bf16*)(a.ws + WS_KV) + (size_t)(kv * 8 + bg) * 8192 * 64;
        const bf16* W1T = (const bf16*)(a.ws + WS_WC1) + (size_t)kv * 128 * 2048;
        const bf16* ap = raw + (size_t)(rb * 64 + rh * 32 + r) * 1024 + 8 * hh;
        const bf16* bp = W1T + (size_t)(ct * 32 + r) * 2048 + 8 * hh;
        f32x16 acc = (f32x16){0.f};
#pragma unroll 8
        for (int ks = 0; ks < 128; ++ks) acc = __builtin_amdgcn_mfma_f32_32x32x16_bf16(*(const bf16x8*)(ap + 16 * ks), *(const bf16x8*)(bp + 16 * ks), acc, 0, 0, 0);
        const int n = ct * 32 + r; float pb = 0.f;
#pragma unroll
        for (int kq = 0; kq < 8; ++kq) pb += tab[TAB_POSB / 4 + (kq * 2 + kv) * 128 + n];
#pragma unroll
        for (int i = 0; i < 16; ++i) { const float x = acc[i] + pb; const float hm = x * __builtin_amdgcn_rcpf(1.f + __builtin_amdgcn_exp2f(-LOG2E * x));
            const int c = rh * 32 + (i & 3) + 8 * (i >> 2) + 4 * hh; HM[c * 136 + n] = (unsigned short)(cvtpk(hm, 0.f) & 0xffffu); }
        __syncthreads();
        if (F.wave < 4) {
            const int rh2 = F.wave >> 1, dt = F.wave & 1;
            const bf16* W2T = (const bf16*)(a.ws + WS_WC2) + (size_t)kv * 64 * 128;
            f32x16 o = (f32x16){0.f};
#pragma unroll
            for (int ks = 0; ks < 8; ++ks) { const bf16x8 af = *(const LAS bf16x8*)(HM + (rh2 * 32 + r) * 136 + 16 * ks + 8 * hh); const bf16x8 bfr = *(const bf16x8*)(W2T + (size_t)(dt * 32 + r) * 128 + 16 * ks + 8 * hh);
                o = __builtin_amdgcn_mfma_f32_32x32x16_bf16(af, bfr, o, 0, 0, 0); }
            const int d = dt * 32 + r;
            bf16* img = (bf16*)(a.ws + (kv ? WS_VCI : WS_KCI)) + (size_t)bg * 512 * 64;
#pragma unroll
            for (int i = 0; i < 16; ++i) { const int c = rb * 64 + rh2 * 32 + (i & 3) + 8 * (i >> 2) + 4 * hh; const float v = c < NCMP ? o[i] : 0.f;
                const size_t off = kv ? ((size_t)(c >> 6) * 4096 + (d >> 5) * 2048 + (c & 63) * 32 + (d & 31)) : ((size_t)(c >> 6) * 4096 + (d >> 3) * 512 + (c & 63) * 8 + (d & 7));
                img[off] = (bf16)(cvtpk(v, 0.f) & 0xffffu); }
        }
        __syncthreads();
    }
}

constexpr int NSA_KS = 0, NSA_VS = 16384, NSA_IMP = 32768, NSA_SELM = NSA_IMP + 64 * 129 * 4, NSA_BT = NSA_SELM + 1024, NSA_OS = NSA_BT + 2048, NSA_LS = NSA_OS + 256 * 65 * 4, NSA_MREF = NSA_LS + 1024, NSA_LIST = NSA_MREF + 1024, NSA_END = NSA_LIST + 2048;
static_assert(NSA_END <= RING_BYTES && NSA_SELM % 16 == 0, "nsa lds map");

constexpr float M_INIT = -1.0e4f;
template <int MODE>
__device__ __forceinline__ void nsa_tiles(LAS unsigned char* lds, const unsigned char* Kimg, const unsigned char* Vimg, int jt0, int jt1, const bf16x8 (&q)[4], int wave, int lane, int tq, int cur, int hd, int qi,
                                          float& m, float& l, att::f32x16 (&o)[2], float linv2) {
    using namespace att;
    const int r = lane & 31, hh = lane >> 5, tql = tq - r;
    LAS unsigned char* Ks = lds + NSA_KS; LAS unsigned char* Vs = lds + NSA_VS;
    const LAS float* BT = (const LAS float*)(lds + NSA_BT) + hd * 128;
    LAS unsigned* IMP = (LAS unsigned*)(lds + NSA_IMP);
    const LAS unsigned* SELM = (const LAS unsigned*)(lds + NSA_SELM);
    const float C2 = 0.125f * LOG2E;
    const float b31 = BT[127];
    dma_tile<8192>(Kimg + (size_t)jt0 * 8192, Ks, wave, lane);
    if (MODE != 0) dma_tile<8192>(Vimg + (size_t)jt0 * 8192, Vs, wave, lane);
#pragma unroll 1
    for (int jt = jt0; jt <= jt1; ++jt) {
        const int sl = (jt - jt0) & 1;
        asm volatile("s_waitcnt vmcnt(0)" ::: "memory"); __syncthreads();
        if (jt < jt1) { dma_tile<8192>(Kimg + (size_t)(jt + 1) * 8192, Ks + (sl ^ 1) * 8192, wave, lane); if (MODE != 0) dma_tile<8192>(Vimg + (size_t)(jt + 1) * 8192, Vs + (sl ^ 1) * 8192, wave, lane); }
        bool far; bool selb = true;
        if (MODE <= 1) far = (tql - 16 * (64 * jt + 63) - 31) >= 113;
        else if (MODE == 2) { far = jt <= cur - 3; selb = (SELM[qi * 4 + (jt >> 5)] >> (jt & 31)) & 1u; if (!__any(selb)) continue; }
        else far = (tql - (64 * jt + 63)) >= 113 && (tql + 31 - 64 * jt) < 512;
        f32x16 p0, p1;
        qk_tile<64>(p0, p1, (lcp)(Ks + sl * 8192), q, r, hh);
        if (far) {
            const float badd = selb ? b31 : NEG_BIG;
            if (MODE != 1) {
                float mx = fmaxf(p0[0], p1[0]);
#pragma unroll
                for (int i = 1; i < 16; ++i) mx = fmaxf(mx, fmaxf(p0[i], p1[i]));
                mx = xhalf_max(mx);
                const float mn = fmaxf(m, mx * C2 + badd);
                if (__any(mn > m)) { const float alpha = __builtin_amdgcn_exp2f(m - mn); l *= alpha; m = mn;
                    if (MODE != 0) { o[0] = o[0] * alpha; o[1] = o[1] * alpha; } }
            }
            const float cc = MODE == 1 ? (b31 - m + linv2) : (badd - m);
            float s = 0.f;
#pragma unroll
            for (int i = 0; i < 16; ++i) { p0[i] = __builtin_amdgcn_exp2f(p0[i] * C2 + cc); p1[i] = __builtin_amdgcn_exp2f(p1[i] * C2 + cc); s += p0[i] + p1[i]; }
            if (MODE != 1) l += s;
        } else {
            if (MODE <= 1) {
                const int db = tq - 31 - 16 * (64 * jt + 4 * hh);
#pragma unroll
                for (int i = 0; i < 16; ++i) { const int ko = (i & 3) + 8 * (i >> 2); const int d0 = db - 16 * ko, d1 = d0 - 512;
                    const float b0 = BT[d0 < 0 ? 0 : (d0 > 127 ? 127 : d0)], b1 = BT[d1 < 0 ? 0 : (d1 > 127 ? 127 : d1)];
                    const float f0 = p0[i] * C2 + b0, f1 = p1[i] * C2 + b1;
                    p0[i] = d0 >= 0 ? f0 : NEG_BIG; p1[i] = d1 >= 0 ? f1 : NEG_BIG;
                    if ((i & 3) == 3) asm volatile("" ::: "memory"); }
            } else {
                const int db = tq - (64 * jt + 4 * hh);
#pragma unroll
                for (int i = 0; i < 16; ++i) { const int ko = (i & 3) + 8 * (i >> 2); const int d0 = db - ko, d1 = d0 - 32;
                    const bool v0 = selb && d0 >= 0 && (MODE != 3 || d0 < 512), v1 = selb && d1 >= 0 && (MODE != 3 || d1 < 512);
                    const float b0 = BT[d0 < 0 ? 0 : (d0 > 127 ? 127 : d0)], b1 = BT[d1 < 0 ? 0 : (d1 > 127 ? 127 : d1)];
                    const float f0 = p0[i] * C2 + b0, f1 = p1[i] * C2 + b1;
                    p0[i] = v0 ? f0 : NEG_BIG; p1[i] = v1 ? f1 : NEG_BIG;
                    if ((i & 3) == 3) asm volatile("" ::: "memory"); }
            }
            if (MODE != 1) {
                float mx = fmaxf(p0[0], p1[0]);
#pragma unroll
                for (int i = 1; i < 16; ++i) mx = fmaxf(mx, fmaxf(p0[i], p1[i]));
                mx = xhalf_max(mx);
                const float mn = fmaxf(m, mx);
                if (__any(mn > m)) { const float alpha = __builtin_amdgcn_exp2f(m - mn); l *= alpha; m = mn;
                    if (MODE != 0) { o[0] = o[0] * alpha; o[1] = o[1] * alpha; } }
            }
            const float cc = MODE == 1 ? (linv2 - m) : -m;
            float s = 0.f;
#pragma unroll
            for (int i = 0; i < 16; ++i) { p0[i] = __builtin_amdgcn_exp2f(p0[i] + cc); p1[i] = __builtin_amdgcn_exp2f(p1[i] + cc); s += p0[i] + p1[i]; }
            if (MODE != 1) l += s;
        }
        if (MODE == 1) {
#pragma unroll
            for (int i4 = 0; i4 < 4; ++i4) {
#pragma unroll
                for (int pp = 0; pp < 2; ++pp) {
                    const float x0 = pp ? p1[4 * i4] : p0[4 * i4], x1 = pp ? p1[4 * i4 + 1] : p0[4 * i4 + 1], x2 = pp ? p1[4 * i4 + 2] : p0[4 * i4 + 2], x3 = pp ? p1[4 * i4 + 3] : p0[4 * i4 + 3];
                    const int js = 16 * jt + 8 * pp + 2 * i4 + hh;
                    const float a = (x0 + x1) + (x2 + 0.5f * x3), bq = 0.5f * x3;
                    if (a > 0.f) { __hip_atomic_fetch_add(IMP + qi * 129 + js, (unsigned)(a * 16777216.f + 0.5f), __ATOMIC_RELAXED, __HIP_MEMORY_SCOPE_WORKGROUP);
                        if (js + 1 < 128 && bq > 0.f) __hip_atomic_fetch_add(IMP + qi * 129 + js + 1, (unsigned)(bq * 16777216.f + 0.5f), __ATOMIC_RELAXED, __HIP_MEMORY_SCOPE_WORKGROUP); }
                }
            }
        }
        if (MODE != 0) pv_tile<64>(o, (lcp)(Vs + sl * 8192), p0, p1, lane);
    }
    __syncthreads();
}

__device__ __forceinline__ unsigned wave_max_u32(unsigned v) {
#pragma unroll
    for (int o = 1; o < 64; o <<= 1) { const unsigned t = (unsigned)__shfl_xor((int)v, o); v = t > v ? t : v; }
    return v;
}


constexpr float FXS = 16384.0f;
__device__ __forceinline__ void nsa_sparse(LAS unsigned char* lds, const unsigned char* Kimg, const unsigned char* Vimg, const bf16* Qunit, int wave, int lane, int cur) {
    using namespace att;
    const int r = lane & 31, hh = lane >> 5, head = r & 3;
    LAS unsigned char* VB = lds + wave * 8192;
    LAS unsigned* LIST = (LAS unsigned*)(lds + NSA_LIST) + wave * 64;
    LAS float* OS = (LAS float*)(lds + NSA_OS); LAS float* LS = (LAS float*)(lds + NSA_LS); const LAS float* MREF = (const LAS float*)(lds + NSA_MREF);
    const LAS unsigned* SELM = (const LAS unsigned*)(lds + NSA_SELM);
    const float b31h = ((const LAS float*)(lds + NSA_BT))[head * 128 + 127];
    const float C2 = 0.125f * LOG2E;
#pragma unroll 1
    for (int jt = 1 + wave; jt <= cur - 3; jt += 8) {
        const bool selq = (SELM[lane * 4 + (jt >> 5)] >> (jt & 31)) & 1u;
        const unsigned long long mask = __ballot(selq);
        const int nsel = __popcll(mask);
        if (nsel == 0) continue;
        const unsigned char* kt = Kimg + (size_t)jt * 8192 + hh * 1024 + r * 16;
        bf16x8 kf[8];
#pragma unroll
        for (int ks = 0; ks < 4; ++ks) { kf[2 * ks] = *(const bf16x8*)(kt + ks * 2048); kf[2 * ks + 1] = *(const bf16x8*)(kt + ks * 2048 + 512); }
#pragma unroll
        for (int i = 0; i < 8; ++i) __builtin_amdgcn_global_load_lds((const unsigned*)(Vimg + (size_t)jt * 8192 + i * 1024 + lane * 16), (LAS unsigned*)(VB + i * 1024), 16, 0, 0);
        if (selq) LIST[__popcll(mask & ((1ull << lane) - 1ull))] = (unsigned)lane;
        const int ngr = (nsel + 7) >> 3;
        int slot = r >> 2; bool valid = slot < nsel;
        asm volatile("s_waitcnt lgkmcnt(0)" ::: "memory");
        int qsel = (int)LIST[valid ? slot : nsel - 1];
        bf16x8 q[4];
#pragma unroll
        for (int ks = 0; ks < 4; ++ks) q[ks] = *(const bf16x8*)(Qunit + (size_t)qsel * 1024 + head * 64 + 16 * ks + 8 * hh);
        asm volatile("s_waitcnt vmcnt(0)" ::: "memory");
#pragma unroll 1
        for (int gi = 0; gi < ngr; ++gi) {
            const int row = qsel * 4 + head; const bool vcur = valid;
            const float cc = b31h - MREF[row];
            f32x16 p0 = (f32x16){0.f}, p1 = (f32x16){0.f};
#pragma unroll
            for (int ks = 0; ks < 4; ++ks) { p0 = __builtin_amdgcn_mfma_f32_32x32x16_bf16(kf[2 * ks], q[ks], p0, 0, 0, 0); p1 = __builtin_amdgcn_mfma_f32_32x32x16_bf16(kf[2 * ks + 1], q[ks], p1, 0, 0, 0); }
            if (gi + 1 < ngr) {
                slot += 8; valid = slot < nsel; qsel = (int)LIST[valid ? slot : nsel - 1];
#pragma unroll
                for (int ks = 0; ks < 4; ++ks) q[ks] = *(const bf16x8*)(Qunit + (size_t)qsel * 1024 + head * 64 + 16 * ks + 8 * hh);
            }
            float sum = 0.f;
#pragma unroll
            for (int i = 0; i < 16; ++i) { p0[i] = __builtin_amdgcn_exp2f(p0[i] * C2 + cc); p1[i] = __builtin_amdgcn_exp2f(p1[i] * C2 + cc); sum += p0[i] + p1[i]; }
            sum = xhalf_sum(sum);
            if (vcur && hh == 0) __hip_atomic_fetch_add((LAS unsigned*)LS + row, (unsigned)__float2int_rn(sum * FXS), __ATOMIC_RELAXED, __HIP_MEMORY_SCOPE_WORKGROUP);
            f32x16 o[2]; o[0] = (f32x16){0.f}; o[1] = o[0];
            pv_tile<64>(o, (lcp)VB, p0, p1, lane);
            if (vcur) {
                LAS unsigned* op = (LAS unsigned*)OS + row * 65 + 4 * hh;
#pragma unroll
                for (int d0 = 0; d0 < 2; ++d0)
#pragma unroll
                    for (int i = 0; i < 16; ++i) __hip_atomic_fetch_add(op + 32 * d0 + (i & 3) + 8 * (i >> 2), (unsigned)__float2int_rn(o[d0][i] * FXS), __ATOMIC_RELAXED, __HIP_MEMORY_SCOPE_WORKGROUP);
            }
        }
        asm volatile("s_waitcnt vmcnt(0) lgkmcnt(0)" ::: "memory");
    }
}

__device__ __forceinline__ void nsa_phase(Frame& F, const Args& a) {
    using namespace att;
    LAS unsigned* IMP = (LAS unsigned*)(F.lds + RING_OFF + NSA_IMP); LAS unsigned* SELM = (LAS unsigned*)(F.lds + RING_OFF + NSA_SELM); LAS float* BTw = (LAS float*)(F.lds + RING_OFF + NSA_BT);
    const float* tab = (const float*)(a.ws + WS_TAB);
    const bf16* Q = (const bf16*)(a.ws + WS_Q); const float* GATES = (const float*)(a.ws + WS_GATES); bf16* MIX = (bf16*)(a.ws + WS_MIX);
#pragma unroll 1
    for (int it = 0; it * F.G + F.vcu < 1024; ++it) {
        int lane = F.lane; asm volatile("" : "+v"(lane));
        const int r = lane & 31, hh = lane >> 5, wave = F.wave, hd = wave & 3, half = wave >> 2;
        int bg, cur;
        if (F.G == 256) { const int s = F.vcu & 31; bg = F.vcu >> 5; cur = it == 0 ? s : (it == 1 ? 63 - s : (it == 2 ? 64 + s : 127 - s)); }
        else { const int u = it * F.G + F.vcu; bg = u >> 7; cur = u & 127; }
        const int b = bg >> 2, g = bg & 3, h = 4 * g + hd, qi = 32 * half + r, tq = 64 * cur + qi;
        const size_t rowq = (size_t)b * SEQ + tq;
        bf16x8 q[4];
#pragma unroll
        for (int ks = 0; ks < 4; ++ks) q[ks] = *(const bf16x8*)(Q + rowq * 1024 + h * 64 + 16 * ks + 8 * hh);
        const float gc = GATES[rowq * 48 + h], gs = GATES[rowq * 48 + 16 + h], gw = GATES[rowq * 48 + 32 + h];
        for (int i = F.tid; i < 64 * 129; i += NWAVES * 64) IMP[i] = 0u;
        if (F.tid < 256) SELM[F.tid] = 0u;
        BTw[F.tid] = tab[TAB_BIAS2 / 4 + (4 * g) * 128 + F.tid];
        __syncthreads();
        const unsigned char* slab = a.ws + WS_KV + (size_t)bg * 8192 * 64 * 2;
        constexpr size_t SLAB = (size_t)8 * 8192 * 64 * 2;
        f32x16 ot[2];
        f32x4* OT = (f32x4*)((float*)(a.ws + WS_XN) + (size_t)blockIdx.x * 16384 + (wave * 64 + lane) * 32);
        {
            const unsigned char* Kc = a.ws + WS_KCI + (size_t)bg * 65536; const unsigned char* Vc = a.ws + WS_VCI + (size_t)bg * 65536;
            const int nct = (4 * cur + 2) / 64;
            float m = M_INIT, l = 0.f; f32x16 oc[2]; oc[0] = (f32x16){0.f}; oc[1] = oc[0];
            nsa_tiles<0>(F.lds + RING_OFF, Kc, Vc, 0, nct, q, wave, lane, tq, cur, hd, qi, m, l, oc, 0.f);
            l = xhalf_sum(l); const float linv2 = -__builtin_amdgcn_logf(l);
            nsa_tiles<1>(F.lds + RING_OFF, Kc, Vc, 0, nct, q, wave, lane, tq, cur, hd, qi, m, l, oc, l > 0.f ? linv2 : NEG_BIG);
#pragma unroll
            for (int i4 = 0; i4 < 4; ++i4) { OT[i4] = (f32x4){oc[0][4 * i4], oc[0][4 * i4 + 1], oc[0][4 * i4 + 2], oc[0][4 * i4 + 3]} * gc; OT[4 + i4] = (f32x4){oc[1][4 * i4], oc[1][4 * i4 + 1], oc[1][4 * i4 + 2], oc[1][4 * i4 + 3]} * gc; }
        }
#pragma unroll 1
        for (int bt = 0; bt < 2; ++bt) {
            const int qs = wave * 8 + bt * 4 + (lane >> 4), l16 = lane & 15;
            unsigned sm = 0u;
            if (cur < 16) {
#pragma unroll
                for (int sI = 0; sI < 8; ++sI) if (l16 + 16 * sI <= cur) sm |= 1u << sI;
            } else {
                unsigned key[8];
#pragma unroll
                for (int sI = 0; sI < 8; ++sI) { const int j = l16 + 16 * sI; const unsigned im = IMP[qs * 129 + j];
                    const bool forced = (j == 0) || (j == cur) || (j == cur - 1);
                    key[sI] = (forced || j > cur) ? 0u : ((((im >> 4) + 1u) << 7) | (unsigned)(127 - j));
                    if (forced) sm |= 1u << sI; }
#pragma unroll 1
                for (int k = 0; k < 13; ++k) {
                    unsigned lm = key[0];
#pragma unroll
                    for (int sI = 1; sI < 8; ++sI) lm = key[sI] > lm ? key[sI] : lm;
                    unsigned rm = lm, t;
                    t = (unsigned)__builtin_amdgcn_update_dpp(0, (int)rm, 0x121, 0xf, 0xf, false); rm = t > rm ? t : rm;
                    t = (unsigned)__builtin_amdgcn_update_dpp(0, (int)rm, 0x122, 0xf, 0xf, false); rm = t > rm ? t : rm;
                    t = (unsigned)__builtin_amdgcn_update_dpp(0, (int)rm, 0x124, 0xf, 0xf, false); rm = t > rm ? t : rm;
                    t = (unsigned)__builtin_amdgcn_update_dpp(0, (int)rm, 0x128, 0xf, 0xf, false); rm = t > rm ? t : rm;
#pragma unroll
                    for (int sI = 0; sI < 8; ++sI) { const bool hit = (key[sI] == rm) && (rm != 0u); sm |= hit ? (1u << sI) : 0u; key[sI] = hit ? 0u : key[sI]; }
                }
            }
#pragma unroll
            for (int w = 0; w < 4; ++w) { const unsigned bits = (((sm >> (2 * w)) & 1u) << l16) | (((sm >> (2 * w + 1)) & 1u) << (l16 + 16));
                if (bits) __hip_atomic_fetch_or(SELM + qs * 4 + w, bits, __ATOMIC_RELAXED, __HIP_MEMORY_SCOPE_WORKGROUP); }
        }
        __syncthreads();
        {
            float m = M_INIT, l = 0.f; f32x16 os[2]; os[0] = (f32x16){0.f}; os[1] = os[0];
            const int nseg = cur < 16 ? 1 : 2;
#pragma unroll 1
            for (int sg = 0; sg < nseg; ++sg) nsa_tiles<2>(F.lds + RING_OFF, slab + 2 * SLAB, slab + 3 * SLAB, sg ? cur - 2 : 0, (cur < 16 || sg) ? cur : 0, q, wave, lane, tq, cur, hd, qi, m, l, os, 0.f);
            if (cur < 16) {
                l = xhalf_sum(l); const float sc = gs / l;
#pragma unroll
                for (int i4 = 0; i4 < 4; ++i4) { OT[i4] += (f32x4){os[0][4 * i4], os[0][4 * i4 + 1], os[0][4 * i4 + 2], os[0][4 * i4 + 3]} * sc; OT[4 + i4] += (f32x4){os[1][4 * i4], os[1][4 * i4 + 1], os[1][4 * i4 + 2], os[1][4 * i4 + 3]} * sc; }
            } else {
                LAS float* OSz = (LAS float*)(F.lds + RING_OFF + NSA_OS); LAS float* LSz = (LAS float*)(F.lds + RING_OFF + NSA_LS); LAS float* MR = (LAS float*)(F.lds + RING_OFF + NSA_MREF);
                const int row = qi * 4 + hd;
                l = xhalf_sum(l);
                if (hh == 0) { MR[row] = m; ((LAS int*)LSz)[row] = __float2int_rn(l * FXS); }
                { LAS float* op = OSz + row * 65 + 4 * hh;
#pragma unroll
                  for (int i = 0; i < 16; ++i) { ((LAS int*)op)[(i & 3) + 8 * (i >> 2)] = __float2int_rn(os[0][i] * FXS); ((LAS int*)op)[32 + (i & 3) + 8 * (i >> 2)] = __float2int_rn(os[1][i] * FXS); } }
                __syncthreads();
                nsa_sparse(F.lds + RING_OFF, slab + 2 * SLAB, slab + 3 * SLAB, Q + ((size_t)b * SEQ + 64 * cur) * 1024 + 4 * g * 64, wave, lane, cur);
                __syncthreads();
                const float sc = gs / (float)((const LAS int*)LSz)[row];
                const LAS int* op = (const LAS int*)OSz + row * 65 + 4 * hh;
#pragma unroll
                for (int i4 = 0; i4 < 4; ++i4) { OT[i4] += (f32x4){(float)op[8 * i4], (float)op[8 * i4 + 1], (float)op[8 * i4 + 2], (float)op[8 * i4 + 3]} * sc; OT[4 + i4] += (f32x4){(float)op[32 + 8 * i4], (float)op[32 + 8 * i4 + 1], (float)op[32 + 8 * i4 + 2], (float)op[32 + 8 * i4 + 3]} * sc; }
                __syncthreads();
            }
        }
        {
            asm volatile("" ::: "memory");
#pragma unroll
            for (int ks = 0; ks < 4; ++ks) q[ks] = *(const bf16x8*)(Q + rowq * 1024 + h * 64 + 16 * ks + 8 * hh);
            float m = M_INIT, l = 0.f; f32x16 ow[2]; ow[0] = (f32x16){0.f}; ow[1] = ow[0];
            nsa_tiles<3>(F.lds + RING_OFF, slab + 4 * SLAB, slab + 5 * SLAB, cur >= 8 ? cur - 8 : 0, cur, q, wave, lane, tq, cur, hd, qi, m, l, ow, 0.f);
            l = xhalf_sum(l); const float sc = gw / l;
#pragma unroll
            for (int i4 = 0; i4 < 4; ++i4) { const f32x4 t0 = OT[i4], t1 = OT[4 + i4];
#pragma unroll
                for (int e = 0; e < 4; ++e) { ot[0][4 * i4 + e] = t0[e] + ow[0][4 * i4 + e] * sc; ot[1][4 * i4 + e] = t1[e] + ow[1][4 * i4 + e] * sc; } }
        }
        bf16* orow = MIX + rowq * MIXW + h * 64 + 4 * hh;
#pragma unroll
        for (int d0 = 0; d0 < 2; ++d0)
#pragma unroll
            for (int i4 = 0; i4 < 4; ++i4) { typedef unsigned u32x2 __attribute__((ext_vector_type(2)));
                u32x2 w; w.x = cvtpk(ot[d0][4 * i4], ot[d0][4 * i4 + 1]); w.y = cvtpk(ot[d0][4 * i4 + 2], ot[d0][4 * i4 + 3]);
                *(u32x2*)(orow + 32 * d0 + 8 * i4) = w; }
    }
}
__device__ __forceinline__ void p0_item(const float* __restrict__ W, int K, int srcN, int sc0, int nvalid, const float* __restrict__ gvec, bf16* __restrict__ WT, int n0, int k0, LAS float* scr, int lane) {
    const bool ok = (lane & 31) < nvalid;
#pragma unroll 8
    for (int i = 0; i < 32; ++i) { const int kk = 2 * i + (lane >> 5); float v = ok ? W[(size_t)(k0 + kk) * srcN + sc0 + (lane & 31)] : 0.f; if (gvec) v *= gvec[k0 + kk]; scr[kk * 33 + (lane & 31)] = v; }
    LDS_WAIT(); asm volatile("" ::: "memory");
    const int c = lane & 7;
#pragma unroll
    for (int j = 0; j < 4; ++j) { const int n = (lane >> 3) + 8 * j; const LAS float* s = scr + (8 * c) * 33 + n;
        v4u o; o.x = pk2(s[0 * 33], s[1 * 33]); o.y = pk2(s[2 * 33], s[3 * 33]); o.z = pk2(s[4 * 33], s[5 * 33]); o.w = pk2(s[6 * 33], s[7 * 33]);
        *(GAS v4u*)(WT + (size_t)(n0 + n) * K + k0 + 8 * c) = o; }
    LDS_WAIT(); asm volatile("" ::: "memory");
}
__device__ __forceinline__ int map_conv(int n) { const int pn = n >> 8, r = n & 255; if (pn < 4 || pn >= 12) return n; const int i = pn - 4; return r < 128 ? 1024 + 128 * i + r : 2048 + 128 * i + (r - 128); }
__device__ __forceinline__ int map_ffi(int n) { const int pn = n >> 8, r = n & 255; return r < 128 ? 128 * pn + r : FFH + 128 * pn + (r - 128); }
__device__ __forceinline__ void map_nsa(int n, int& sc, int& nv) { nv = 32; if (n < 2560) sc = n; else if (n < 3072) sc = 2608 + (n - 2560); else if (n < 3120) { sc = 2560 + (n - 3072); nv = (3120 - n) < 32 ? (3120 - n) : 32; } else { sc = 0; nv = 0; } }

__device__ __forceinline__ void p0_prologue(Frame& F, const Args& a) {
    LAS float* scr = (LAS float*)(F.lds + RING_OFF + F.wave * 16384);
    const int gw = F.vcu * NWAVES + F.wave, NGW = F.G * NWAVES;
    unsigned char* ws = a.ws;
    constexpr int I_CONV = 16 * (CONV_N / 32), I_NSA = 16 * (NSA_N / 32), I_OUT = 24 * 32, I_FFI = 16 * 176, I_FFO = 44 * 32, I_MKV = 16 * 32, I_C1 = 32 * 4, I_C2 = 2 * 2;
    constexpr int NITEMS = I_CONV + I_NSA + 2 * I_OUT + 2 * I_FFI + 2 * I_FFO + 2 * I_MKV + 2 * I_C1 + 2 * I_C2;
    for (int it = gw; it < NITEMS; it += NGW) {
        int r = it;
        if (r < I_CONV) { const int nb = r % (CONV_N / 32), kb = r / (CONV_N / 32); p0_item(a.in[6], 1024, CONV_N, map_conv(32 * nb), 32, a.in[2], (bf16*)(ws + WS_WCONV), 32 * nb, 64 * kb, scr, F.lane); continue; } r -= I_CONV;
        if (r < I_NSA) { const int nb = r % (NSA_N / 32), kb = r / (NSA_N / 32); int sc, nv; map_nsa(32 * nb, sc, nv); p0_item(a.in[8], 1024, NSA_SRC, sc, nv, a.in[2] + DM, (bf16*)(ws + WS_WNSA), 32 * nb, 64 * kb, scr, F.lane); continue; } r -= I_NSA;
        if (r < 2 * I_OUT) { const int l = r / I_OUT; r -= l * I_OUT; const int nb = r % 32, kb = r / 32; p0_item(a.in[17] + (size_t)l * MIXW * DM, MIXW, DM, 32 * nb, 32, nullptr, (bf16*)(ws + WS_WOUT) + (size_t)l * DM * MIXW, 32 * nb, 64 * kb, scr, F.lane); continue; } r -= 2 * I_OUT;
        if (r < 2 * I_FFI) { const int l = r / I_FFI; r -= l * I_FFI; const int nb = r % 176, kb = r / 176; p0_item(a.in[18] + (size_t)l * DM * 2 * FFH, DM, 2 * FFH, map_ffi(32 * nb), 32, a.in[4] + l * DM, (bf16*)(ws + WS_WFFI) + (size_t)l * 2 * FFH * DM, 32 * nb, 64 * kb, scr, F.lane); continue; } r -= 2 * I_FFI;
        if (r < 2 * I_FFO) { const int l = r / I_FFO; r -= l * I_FFO; const int nb = r % 32, kb = r / 32; p0_item(a.in[19] + (size_t)l * FFH * DM, FFH, DM, 32 * nb, 32, nullptr, (bf16*)(ws + WS_WFFO) + (size_t)l * DM * FFH, 32 * nb, 64 * kb, scr, F.lane); continue; } r -= 2 * I_FFO;
        if (r < 2 * I_MKV) { const int l = r / I_MKV; r -= l * I_MKV; const int nb = r % 32, kb = r / 32; p0_item(a.in[16] + (size_t)l * DM * 1024, DM, 1024, 32 * nb, 32, nullptr, (bf16*)(ws + WS_WMKV) + (size_t)l * 1024 * DM, 32 * nb, 64 * kb, scr, F.lane); continue; } r -= 2 * I_MKV;
        if (r < 2 * I_C1) { const int l = r / I_C1; r -= l * I_C1; const int nb = r % 4, kb = r / 4; p0_item(a.in[l ? 13 : 10], 2048, 128, 32 * nb, 32, nullptr, (bf16*)(ws + WS_WC1) + (size_t)l * 128 * 2048, 32 * nb, 64 * kb, scr, F.lane); continue; } r -= 2 * I_C1;
        { const int l = r / I_C2; r -= l * I_C2; const int nb = r % 2, kb = r / 2; p0_item(a.in[l ? 14 : 11], 128, 64, 32 * nb, 32, nullptr, (bf16*)(ws + WS_WC2) + (size_t)l * 64 * 128, 32 * nb, 64 * kb, scr, F.lane); }
    }
    bf16* XN = (bf16*)(ws + WS_XN); float* ST = (float*)(ws + WS_STATS);
    for (int m = gw; m < MTOK; m += NGW) {
        const GAS f32x4* xr = (const GAS f32x4*)(a.in[0] + (size_t)m * DM) + F.lane; f32x4 v[4]; float s = 0.f;
#pragma unroll
        for (int j = 0; j < 4; ++j) { v[j] = xr[64 * j]; s += (v[j].x * v[j].x + v[j].y * v[j].y) + (v[j].z * v[j].z + v[j].w * v[j].w); }
        s = wave_sum(s);
        GAS unsigned long long* o8 = (GAS unsigned long long*)(XN + (size_t)m * DM) + F.lane;
#pragma unroll
        for (int j = 0; j < 4; ++j) o8[64 * j] = (unsigned long long)pk2(v[j].x, v[j].y) | ((unsigned long long)pk2(v[j].z, v[j].w) << 32);
        if (F.lane < 16) ST[(size_t)m * 16 + F.lane] = F.lane == 0 ? s : 0.f;
    }
    bf16* MEMN = (bf16*)(ws + WS_MEMN);
    for (int r = gw; r < 2 * BATCH * NMEM; r += NGW) { const int l = r / (BATCH * NMEM), row = r % (BATCH * NMEM);
        const GAS f32x4* xr = (const GAS f32x4*)(a.in[1] + (size_t)row * DM) + F.lane; const GAS f32x4* gr = (const GAS f32x4*)(a.in[3] + (size_t)l * DM) + F.lane; f32x4 v[4]; float s = 0.f;
#pragma unroll
        for (int j = 0; j < 4; ++j) { v[j] = xr[64 * j]; s += (v[j].x * v[j].x + v[j].y * v[j].y) + (v[j].z * v[j].z + v[j].w * v[j].w); }
        const float rs = rsqrtf(wave_sum(s) * (1.f / DM) + 1e-6f);
        GAS unsigned long long* o8 = (GAS unsigned long long*)(MEMN + (size_t)r * DM) + F.lane;
#pragma unroll
        for (int j = 0; j < 4; ++j) { const f32x4 g = gr[64 * j]; o8[64 * j] = (unsigned long long)pk2(v[j].x * rs * g.x, v[j].y * rs * g.y) | ((unsigned long long)pk2(v[j].z * rs * g.z, v[j].w * rs * g.w) << 32); }
    }
}
__device__ __forceinline__ void p_final(Frame& F, const Args& a) {
    const int gw = F.vcu * NWAVES + F.wave, NGW = F.G * NWAVES; const float* ST = (const float*)(a.ws + WS_STATS);
    for (int m = gw; m < MTOK; m += NGW) {
        const float rs = pg8::row_rstd(ST, m);
        GAS f32x4* xr = (GAS f32x4*)(a.out + (size_t)m * DM) + F.lane; const GAS f32x4* gr = (const GAS f32x4*)(a.in[5]) + F.lane;
#pragma unroll
        for (int j = 0; j < 4; ++j) xr[64 * j] = xr[64 * j] * rs * gr[64 * j];
    }
}

__global__ void __launch_bounds__(NWAVES * 64, 2) mega_fwd(Args args) {
    extern __shared__ __attribute__((aligned(16))) unsigned char lds[];
    unsigned char* ws = args.ws;
#define MKF() Frame F = mk_frame(lds, ws)
    { MKF(); for (int u = F.tid; u < (LDS_BYTES - LDSCTL_OFF) / 4; u += NWAVES * 64) ((LAS unsigned*)(F.lds + LDSCTL_OFF))[u] = 0u; }
    __syncthreads();
    LAS unsigned char* const ldsb = (LAS unsigned char*)lds; const int GG = gridDim.x;
    const int lo = args.ph_lo, hi = args.ph_hi;
    XcdBarrier bar; bar.bar = (unsigned*)(ws + WS_CTL) + CW_BAR + args.li * XCD_BAR_WORDS; bar.x = 0; bar.st = nullptr;
    if (hi - lo > 1) bar = xcd_barrier_post((unsigned*)(ws + WS_CTL) + CW_BAR + args.li * XCD_BAR_WORDS, (volatile LAS unsigned*)(ldsb + MISC_OFF) + 8);
#ifndef PHMASK
#define PHMASK 0xFFFF
#endif
#define IN(k) (((PHMASK >> (k)) & 1) && lo <= (k) && (k) < hi)
#define SEAM(k) do { if (IN(k) && IN((k) + 1)) xcd_barrier(bar); } while (0)
    bf16* XN = (bf16*)(ws + WS_XN); bf16* MIX = (bf16*)(ws + WS_MIX); float* ST = (float*)(ws + WS_STATS);
    float* H = args.out;

    if (IN(0)) { MKF(); p0_tables(F, args); p0_prologue(F, args); } SEAM(0);
    if (IN(1)) {
        if (blockIdx.x >= 128) {
            pg8::Gemm g{(const bf16*)(ws + WS_MEMN), (const bf16*)(ws + WS_WMKV), 1024, 2048, DM, DM}; pg8::DiagOrder S{128, (int)blockIdx.x - 128};
            pg8::EpiMemKV E{(bf16*)(ws + WS_MKI), (bf16*)(ws + WS_MVI)};
            pg8::gemm_phase<pg8::EpiMemKV, pg8::DiagOrder, true, true>(ldsb + RING_OFF, g, S, E);
        }
        pg8::Gemm g{XN, (const bf16*)(ws + WS_WCONV), MTOK, CONV_N, DM, DM}; pg8::StaticOrder S; S.init(MTOK, CONV_N, GG, (int)blockIdx.x);
        pg8::EpiConv E{(bf16*)(ws + WS_UB), (bf16*)(ws + WS_V), (bf16*)(ws + WS_XQ0), ST};
        pg8::gemm_phase<pg8::EpiConv, pg8::StaticOrder, true, true>(ldsb + RING_OFF, g, S, E);
    } SEAM(1);
    if (IN(2)) { MKF(); conv_phase(F, args); memattn_phase(F, args, 0, (const bf16*)(ws + WS_XQ0)); }
    SEAM(2);
#define LAYER_TAIL(l, pb) \
        if (IN(pb)) { \
            pg8::Gemm g{MIX, (const bf16*)(ws + WS_WOUT) + (size_t)(l) * DM * MIXW, MTOK, DM, MIXW, MIXW}; pg8::StaticOrder S; S.init(MTOK, DM, GG, (int)blockIdx.x); \
            pg8::EpiRes E{(l) ? H : args.in[0], H, XN, ST}; \
            pg8::gemm_phase<pg8::EpiRes, pg8::StaticOrder, true, true>(ldsb + RING_OFF, g, S, E); \
        } SEAM(pb); \
        if (IN((pb) + 1)) { \
            pg8::Gemm g{XN, (const bf16*)(ws + WS_WFFI) + (size_t)(l) * 2 * FFH * DM, MTOK, 2 * FFH, DM, DM}; pg8::StaticOrder S; S.init(MTOK, 2 * FFH, GG, (int)blockIdx.x); \
            pg8::EpiSwiglu E{(bf16*)(ws + WS_HID), ST}; \
            pg8::gemm_phase<pg8::EpiSwiglu, pg8::StaticOrder, true, true>(ldsb + RING_OFF, g, S, E); \
        } SEAM((pb) + 1); \
        if (IN((pb) + 2)) { \
            pg8::Gemm g{(const bf16*)(ws + WS_HID), (const bf16*)(ws + WS_WFFO) + (size_t)(l) * DM * FFH, MTOK, DM, FFH, FFH}; pg8::StaticOrder S; S.init(MTOK, DM, GG, (int)blockIdx.x); \
            pg8::EpiRes E{H, H, XN, ST}; \
            pg8::gemm_phase<pg8::EpiRes, pg8::StaticOrder, true, true>(ldsb + RING_OFF, g, S, E); \
        } SEAM((pb) + 2);
    LAYER_TAIL(0, 3)
    if (IN(6)) {
        pg8::Gemm g{XN, (const bf16*)(ws + WS_WNSA), MTOK, NSA_N, DM, DM}; pg8::StaticOrder S; S.init(MTOK, NSA_N, GG, (int)blockIdx.x);
        pg8::EpiNsa E{(bf16*)(ws + WS_Q), (bf16*)(ws + WS_KV), (bf16*)(ws + WS_XQ1), (float*)(ws + WS_GATES), ST};
        pg8::gemm_phase<pg8::EpiNsa, pg8::StaticOrder, true, true>(ldsb + RING_OFF, g, S, E);
    } SEAM(6);
    if (IN(7)) { MKF(); cmpmlp_phase(F, args); memattn_phase(F, args, 1, (const bf16*)(ws + WS_XQ1)); } SEAM(7);
    if (IN(8)) { MKF(); nsa_phase(F, args);
#ifdef PROBE_NSA2
        __syncthreads(); nsa_phase(F, args);
#endif
    } SEAM(8);
    LAYER_TAIL(1, 9)
#undef LAYER_TAIL
    if (IN(12)) { MKF(); p_final(F, args); }
#undef IN
#undef SEAM
}

static void launch_mega(const Args& base, int lo, int hi, int grid, hipStream_t stream, int li = 0) {
    Args a = base; a.ph_lo = lo; a.ph_hi = hi; a.li = li;
    hipLaunchKernelGGL(mega_fwd, dim3(grid), dim3(NWAVES * 64), LDS_BYTES, stream, a);
}
extern "C" void kernel_launch(void* const* d_in, const int* in_sizes, int n_in, void* d_out, int out_size, void* d_ws, size_t ws_size, hipStream_t stream) {
    static int grid = 0;
    if (grid == 0) {
        int dev = 0, cus = 0;
        if (n_in != 20 || out_size != MTOK * DM || ws_size < WS_END) { fprintf(stderr, "kernel_launch: unexpected shapes (n_in %d out %d ws %zu)\n", n_in, out_size, ws_size); grid = -1; return; }
        if (hipGetDevice(&dev) != hipSuccess || hipDeviceGetAttribute(&cus, hipDeviceAttributeMultiprocessorCount, dev) != hipSuccess) { grid = -1; return; }
        if (hipFuncSetAttribute((const void*)mega_fwd, hipFuncAttributeMaxDynamicSharedMemorySize, LDS_BYTES) != hipSuccess) { fprintf(stderr, "kernel_launch: hipFuncSetAttribute failed\n"); grid = -1; return; }
        grid = cus;
    }
    if (grid < 0) return;
    (void)hipMemsetAsync((char*)d_ws + WS_CTL, 0, CTL_ZERO_BYTES, stream);
    Args a{};
    for (int i = 0; i < 20; ++i) a.in[i] = (const float*)d_in[i];
    a.out = (float*)d_out; a.ws = (unsigned char*)d_ws;
    launch_mega(a, 0, 13, grid, stream, 0);
}
```
